# Optimizing an MI355X kernel written in HIP

```python
import math
import jax, jax.numpy as jnp
from jax import lax
import numpy as np

D_MODEL = 1024
BATCH = 32
SEQ = 256
DEPTH = 2
DEC_BATCH = 4
DEC_SEQ = 2048
PAST_LEN = 512

GRID_W = 64
N_EVEN = (DEPTH + 1) // 2
N_ODD = DEPTH // 2
HALF = D_MODEL // 2
S5_P = 16
S5_G = HALF // S5_P
S5_N = 64
S5_DT_MIN = 0.001
S5_DT_MAX = 0.1
DA_DK = 64
DA_DV = 2 * DA_DK
DA_HEADS = HALF // DA_DV
ROPE_THETA = 10000.0
ROPE_F = DA_DK // 4
Q_BLOCK = 128
SC_WIDTH = 3
LRU_WIDTH = HALF
LRU_BLOCKS = 8
LRU_BS = LRU_WIDTH // LRU_BLOCKS
LRU_CONV = 4
LRU_C = 8.0
D_FF = 2816
FFN_CONV = 3
AB_IN = 4 * HALF
CD_IN = 3 * HALF + 2 * LRU_WIDTH
EPS = 1e-6

kernel_name = "hybrid_s5_diffattn_shortconv_rglru_dit_step"


def rmsnorm(x, g):
    x32 = x.astype(jnp.float32)
    y = x32 * lax.rsqrt(jnp.mean(x32 * x32, axis=-1, keepdims=True) + EPS)
    return (y * g.astype(jnp.float32)).astype(x.dtype)


def dwconv(x, w, left):
    k = w.shape[0]
    L = x.shape[1]
    xp = jnp.pad(x, ((0, 0), (left, k - 1 - left), (0, 0)))
    out = xp[:, 0:L] * w[0]
    for j in range(1, k):
        out = out + xp[:, j:j + L] * w[j]
    return out


def rope_tables(L):
    rows = L // GRID_W
    t_row = jnp.repeat(jnp.arange(rows), GRID_W).astype(jnp.float32)
    t_col = jnp.tile(jnp.arange(GRID_W), rows).astype(jnp.float32)
    inv = ROPE_THETA ** (-jnp.arange(ROPE_F, dtype=jnp.float32) / ROPE_F)
    ang = jnp.stack([t_row[:, None] * inv, t_col[:, None] * inv], axis=1)
    return jnp.cos(ang), jnp.sin(ang)


def rope2d(x, cos, sin):
    xs = x.reshape(x.shape[:-1] + (2, 2, ROPE_F))
    x1, x2 = xs[..., 0, :], xs[..., 1, :]
    c = cos[:, None, None].astype(x.dtype)
    s = sin[:, None, None].astype(x.dtype)
    o = jnp.stack([x1 * c - x2 * s, x2 * c + x1 * s], axis=-2)
    return o.reshape(x.shape)


def modulation(cv, w_mod, b_mod):
    return (jax.nn.silu(cv) @ w_mod + b_mod).reshape(cv.shape[0], 6, D_MODEL)


def _pre(x, m, g, j):
    return rmsnorm(x, g) * (1 + m[:, 3 * j + 1, None]) + m[:, 3 * j, None]


def _post(x, y, m, g, j):
    return x + m[:, 3 * j + 2, None] * rmsnorm(y, g)


def _cplx_comb(e1, e2):
    a1r, a1i, b1r, b1i = e1
    a2r, a2i, b2r, b2i = e2
    return (a2r * a1r - a2i * a1i, a2r * a1i + a2i * a1r,
            a2r * b1r - a2i * b1i + b2r, a2r * b1i + a2i * b1r + b2i)


def _real_comb(e1, e2):
    a1, b1 = e1
    a2, b2 = e2
    return (a1 * a2, a2 * b1 + b2)


def s5_direction(u, lam_re, lam_im, log_dt, b_w, c_w, h0, reverse):
    lam_re = lam_re.astype(jnp.float32)
    lam_im = lam_im.astype(jnp.float32)
    dt = jnp.exp(log_dt.astype(jnp.float32))[:, None]
    mag = jnp.exp(lam_re * dt)
    ang = lam_im * dt
    ab_r, ab_i = mag * jnp.cos(ang), mag * jnp.sin(ang)
    den = lam_re * lam_re + lam_im * lam_im
    nr, ni = ab_r - 1.0, ab_i
    f_r = (nr * lam_re + ni * lam_im) / den
    f_i = (ni * lam_re - nr * lam_im) / den
    b_w = b_w.astype(jnp.float32)
    c_w = c_w.astype(jnp.float32)
    bu_r = jnp.einsum('blgp,gnp->blgn', u, b_w[0])
    bu_i = jnp.einsum('blgp,gnp->blgn', u, b_w[1])
    br = f_r * bu_r - f_i * bu_i
    bi = f_r * bu_i + f_i * bu_r
    if reverse:
        br, bi = jnp.flip(br, axis=1), jnp.flip(bi, axis=1)
    if h0 is not None:
        h0r, h0i = h0[0], h0[1]
        br = br.at[:, 0].add(ab_r * h0r - ab_i * h0i)
        bi = bi.at[:, 0].add(ab_r * h0i + ab_i * h0r)
    ar = jnp.broadcast_to(ab_r, br.shape)
    ai = jnp.broadcast_to(ab_i, br.shape)
    _, _, hr, hi = lax.associative_scan(_cplx_comb, (ar, ai, br, bi), axis=1)
    final = jnp.stack([hr[:, -1], hi[:, -1]], axis=1)
    if reverse:
        hr, hi = jnp.flip(hr, axis=1), jnp.flip(hi, axis=1)
    y = jnp.einsum('blgn,gpn->blgp', hr, c_w[0]) - jnp.einsum('blgn,gpn->blgp', hi, c_w[1])
    return y, final


def diff_attention(q, keys, vals, lam):
    b, lq = q.shape[0], q.shape[1]
    nb = lq // Q_BLOCK
    qb = q.reshape((b, nb, Q_BLOCK) + q.shape[2:]).swapaxes(0, 1)
    scale = 1.0 / math.sqrt(DA_DK)

    def one_block(qblk):
        s = jnp.einsum('bqhmd,bkhmd->bhmqk', qblk, keys, preferred_element_type=jnp.float32) * scale
        p = jax.nn.softmax(s, axis=-1)
        w = p[:, :, 0] - lam * p[:, :, 1]
        return jnp.einsum('bhqk,bkhe->bqhe', w.astype(vals.dtype), vals)

    o = lax.map(one_block, qb)
    return o.swapaxes(0, 1).reshape(b, lq, DA_HEADS, DA_DV)


def mixer_ab(h, w_in, w_out, lam_re, lam_im, log_dt, s5_b, s5_c, s5_d, w_glu, b_glu,
             da_lam, da_g, lam_init, rope, k_ctx, v_ctx, s5_h0):
    b, L, _ = h.shape
    proj = h @ w_in
    u, q, k, v = jnp.split(proj, [HALF, 2 * HALF, 3 * HALF], axis=-1)
    u4 = u.reshape(b, L, S5_G, S5_P).astype(jnp.float32)
    ys = u4 * s5_d.reshape(S5_G, S5_P).astype(jnp.float32)
    finals = []
    for d in range(2):
        h0 = None if s5_h0 is None else jnp.moveaxis(s5_h0[:, d].astype(jnp.float32), 1, 0)
        y_d, fin = s5_direction(u4, lam_re[d], lam_im[d], log_dt[d], s5_b[d], s5_c[d], h0, d == 1)
        ys = ys + y_d
        finals.append(fin)
    s5_state = jnp.stack(finals, axis=1).astype(h.dtype)
    ys = jax.nn.gelu(ys.reshape(b, L, HALF)).astype(h.dtype)
    y_a = ys * jax.nn.sigmoid(ys @ w_glu + b_glu)
    q = q.reshape(b, L, DA_HEADS, 2, DA_DK)
    k = k.reshape(b, L, DA_HEADS, 2, DA_DK)
    v = v.reshape(b, L, DA_HEADS, DA_DV)
    dl = da_lam.astype(jnp.float32)
    lam = jnp.exp(jnp.sum(dl[0] * dl[1])) - jnp.exp(jnp.sum(dl[2] * dl[3])) + lam_init
    if k_ctx is None:
        keys, vals, qr = k, v, q
    else:
        cos, sin = rope
        qr = rope2d(q, cos, sin)
        keys = jnp.concatenate([rope2d(k, cos, sin), k_ctx.astype(h.dtype)], axis=1)
        vals = jnp.concatenate([v, v_ctx.astype(h.dtype)], axis=1)
    o = diff_attention(qr, keys, vals, lam)
    o = rmsnorm(o, da_g) * (1.0 - lam_init)
    y_b = o.reshape(b, L, HALF)
    out = jnp.concatenate([y_a, y_b], axis=-1) @ w_out
    return out, k, v, s5_state


def mixer_cd(h, w_in, w_out, sc_w, conv_w, conv_b, w_a, b_a, w_x, b_x, lru_lam, h0):
    b, L, _ = h.shape
    proj = h @ w_in
    xin, bg, cg, xr, gb = jnp.split(proj, [HALF, 2 * HALF, 3 * HALF, 3 * HALF + LRU_WIDTH], axis=-1)
    y_c = bg * dwconv(cg * xin, sc_w, 1)
    xc = dwconv(xr, conv_w, 2) + conv_b
    xc32 = xc.astype(jnp.float32)
    xb = xc32.reshape(b, L, LRU_BLOCKS, LRU_BS)
    hsum = None
    finals = []
    for d in range(2):
        r = jax.nn.sigmoid(jnp.einsum('blkc,kcd->blkd', xb, w_a[d].astype(jnp.float32)).reshape(b, L, LRU_WIDTH) + b_a[d])
        i = jax.nn.sigmoid(jnp.einsum('blkc,kcd->blkd', xb, w_x[d].astype(jnp.float32)).reshape(b, L, LRU_WIDTH) + b_x[d])
        log_a = -LRU_C * r * jax.nn.softplus(-lru_lam[d].astype(jnp.float32))
        a = jnp.exp(log_a)
        bval = jnp.sqrt(-jnp.expm1(2.0 * log_a)) * (i * xc32)
        if d == 1:
            a, bval = jnp.flip(a, axis=1), jnp.flip(bval, axis=1)
        if h0 is not None:
            bval = bval.at[:, 0].add(a[:, 0] * h0[:, d].astype(jnp.float32))
        _, hs = lax.associative_scan(_real_comb, (a, bval), axis=1)
        finals.append(hs[:, -1])
        if d == 1:
            hs = jnp.flip(hs, axis=1)
        hsum = hs if hsum is None else hsum + hs
    y_d = hsum.astype(h.dtype) * jax.nn.gelu(gb)
    out = jnp.concatenate([y_c, y_d], axis=-1) @ w_out
    return out, jnp.stack(finals, axis=1).astype(h.dtype)


def conv_ffn(h, w_up, cw, cb, w_down):
    u = dwconv(h @ w_up, cw, 1) + cb
    g, val = jnp.split(u, 2, axis=-1)
    return (jax.nn.gelu(g) * val) @ w_down


def setup_inputs(seed: int = 0) -> dict:
    key = jax.random.key(seed)
    ks = iter(jax.random.split(key, 48))
    f32 = jnp.float32

    def nrm(shape, scale):
        return jax.random.normal(next(ks), shape, f32) * scale

    lam_im = math.pi * jnp.arange(S5_N, dtype=f32)
    s5_lam_im = jnp.broadcast_to(lam_im, (N_EVEN, 2, S5_G, S5_N)) + nrm((N_EVEN, 2, S5_G, S5_N), 0.01)
    a_init = jax.random.uniform(next(ks), (N_ODD, 2, LRU_WIDTH), f32, 0.9, 0.999) ** (1.0 / LRU_C)
    return {
        "x_prompt": nrm((BATCH, SEQ, D_MODEL), 1.0),
        "x_sample": nrm((DEC_BATCH, DEC_SEQ, D_MODEL), 1.0),
        "cache_attn_k": nrm((DEC_BATCH, N_EVEN, PAST_LEN, DA_HEADS, 2, DA_DK), 1.0),
        "cache_attn_v": nrm((DEC_BATCH, N_EVEN, PAST_LEN, DA_HEADS, DA_DV), 1.0),
        "state_s5": nrm((DEC_BATCH, N_EVEN, 2, 2, S5_G, S5_N), 0.5),
        "state_rglru": nrm((DEC_BATCH, N_ODD, 2, LRU_WIDTH), 0.5),
        "c": nrm((DEC_BATCH, D_MODEL), 1.0),
        "c_ctx": nrm((D_MODEL,), 1.0),
        "w_mod": nrm((DEPTH, D_MODEL, 6 * D_MODEL), 0.5 * D_MODEL ** -0.5),
        "b_mod": nrm((DEPTH, 6 * D_MODEL), 0.02),
        "norm_g": 1.0 + nrm((DEPTH, 4, D_MODEL), 0.02),
        "w_in_ab": nrm((N_EVEN, D_MODEL, AB_IN), D_MODEL ** -0.5),
        "w_out_ab": nrm((N_EVEN, 2 * HALF, D_MODEL), (2 * HALF) ** -0.5),
        "s5_lam_re": -0.5 + nrm((N_EVEN, 2, S5_G, S5_N), 0.01),
        "s5_lam_im": s5_lam_im,
        "s5_log_dt": jax.random.uniform(next(ks), (N_EVEN, 2, S5_G), f32, math.log(S5_DT_MIN), math.log(S5_DT_MAX)),
        "s5_b": nrm((N_EVEN, 2, 2, S5_G, S5_N, S5_P), S5_P ** -0.5),
        "s5_c": nrm((N_EVEN, 2, 2, S5_G, S5_P, S5_N), (2 * S5_N) ** -0.5),
        "s5_d": nrm((N_EVEN, HALF), 1.0),
        "s5_w_glu": nrm((N_EVEN, HALF, HALF), HALF ** -0.5),
        "s5_b_glu": nrm((N_EVEN, HALF), 0.02),
        "da_lam": nrm((N_EVEN, 4, DA_DK), 0.1),
        "da_g": 1.0 + nrm((N_EVEN, DA_DV), 0.02),
        "w_in_cd": nrm((N_ODD, D_MODEL, CD_IN), D_MODEL ** -0.5),
        "w_out_cd": nrm((N_ODD, 2 * HALF, D_MODEL), (2 * HALF) ** -0.5),
        "sc_conv_w": nrm((N_ODD, SC_WIDTH, HALF), SC_WIDTH ** -0.5),
        "lru_conv_w": nrm((N_ODD, LRU_CONV, LRU_WIDTH), LRU_CONV ** -0.5),
        "lru_conv_b": nrm((N_ODD, LRU_WIDTH), 0.02),
        "lru_w_a": nrm((N_ODD, 2, LRU_BLOCKS, LRU_BS, LRU_BS), LRU_BS ** -0.5),
        "lru_b_a": nrm((N_ODD, 2, LRU_WIDTH), 0.1),
        "lru_w_x": nrm((N_ODD, 2, LRU_BLOCKS, LRU_BS, LRU_BS), LRU_BS ** -0.5),
        "lru_b_x": nrm((N_ODD, 2, LRU_WIDTH), 0.1),
        "lru_lam": jnp.log(a_init / (1.0 - a_init)),
        "ffn_w_up": nrm((DEPTH, D_MODEL, 2 * D_FF), D_MODEL ** -0.5),
        "ffn_conv_w": nrm((DEPTH, FFN_CONV, 2 * D_FF), FFN_CONV ** -0.5),
        "ffn_conv_b": nrm((DEPTH, 2 * D_FF), 0.02),
        "ffn_w_down": nrm((DEPTH, D_FF, D_MODEL), D_FF ** -0.5),
    }


def reference(x_prompt, x_sample, cache_attn_k, cache_attn_v, state_s5, state_rglru, c, c_ctx,
              w_mod, b_mod, norm_g, w_in_ab, w_out_ab, s5_lam_re, s5_lam_im, s5_log_dt, s5_b, s5_c,
              s5_d, s5_w_glu, s5_b_glu, da_lam, da_g, w_in_cd, w_out_cd, sc_conv_w, lru_conv_w,
              lru_conv_b, lru_w_a, lru_b_a, lru_w_x, lru_b_x, lru_lam, ffn_w_up, ffn_conv_w,
              ffn_conv_b, ffn_w_down):
    rope_lat = rope_tables(x_sample.shape[1])
    xp, xs = x_prompt, x_sample
    new_k, new_v, new_s5, new_lru = [], [], [], []
    for l in range(DEPTH):
        m_p = modulation(c_ctx[None], w_mod[l], b_mod[l])
        m_s = modulation(c, w_mod[l], b_mod[l])
        hp = _pre(xp, m_p, norm_g[l, 0], 0)
        hs = _pre(xs, m_s, norm_g[l, 0], 0)
        e = l // 2
        if l % 2 == 0:
            lam_init = 0.8 - 0.6 * math.exp(-0.3 * l)
            wts = (w_in_ab[e], w_out_ab[e], s5_lam_re[e], s5_lam_im[e], s5_log_dt[e], s5_b[e], s5_c[e],
                   s5_d[e], s5_w_glu[e], s5_b_glu[e], da_lam[e], da_g[e], lam_init)
            yp, kc, vc, s5c = mixer_ab(hp, *wts, None, None, None, None)
            ys, _, _, _ = mixer_ab(hs, *wts, rope_lat, cache_attn_k[:, e], cache_attn_v[:, e], state_s5[:, e])
            new_k.append(kc)
            new_v.append(vc)
            new_s5.append(s5c)
        else:
            wts = (w_in_cd[e], w_out_cd[e], sc_conv_w[e], lru_conv_w[e], lru_conv_b[e], lru_w_a[e],
                   lru_b_a[e], lru_w_x[e], lru_b_x[e], lru_lam[e])
            yp, lc = mixer_cd(hp, *wts, None)
            ys, _ = mixer_cd(hs, *wts, state_rglru[:, e])
            new_lru.append(lc)
        xp = _post(xp, yp, m_p, norm_g[l, 1], 0)
        xs = _post(xs, ys, m_s, norm_g[l, 1], 0)
        ffw = (ffn_w_up[l], ffn_conv_w[l], ffn_conv_b[l], ffn_w_down[l])
        xp = _post(xp, conv_ffn(_pre(xp, m_p, norm_g[l, 2], 1), *ffw), m_p, norm_g[l, 3], 1)
        xs = _post(xs, conv_ffn(_pre(xs, m_s, norm_g[l, 2], 1), *ffw), m_s, norm_g[l, 3], 1)
    y_prompt, y_sample = xp, xs
    new_attn_k = jnp.stack(new_k, axis=1)
    new_attn_v = jnp.stack(new_v, axis=1)
    new_s5_state = jnp.stack(new_s5, axis=1)
    new_rglru_state = jnp.stack(new_lru, axis=1)
    return (y_prompt, y_sample, new_attn_k, new_attn_v, new_s5_state, new_rglru_state)
```

```cpp
#include <hip/hip_runtime.h>
#include <hip/hip_cooperative_groups.h>
#include <cstdio>
namespace cg = cooperative_groups;

#define LAS __attribute__((address_space(3)))
typedef unsigned short bf16_t;
typedef short bf16x8 __attribute__((ext_vector_type(8)));
typedef float f32x4 __attribute__((ext_vector_type(4)));
typedef float f32x2 __attribute__((ext_vector_type(2)));
typedef unsigned u32x4 __attribute__((ext_vector_type(4)));
typedef unsigned u32x2 __attribute__((ext_vector_type(2)));

constexpr int NTOK = 16384, DM = 1024, NPROMPT = 8192;
constexpr int LDS_BYTES = 147456;
constexpr size_t MiB = 1ull << 20;
constexpr size_t W_INAB = 0, W_GLU = 4 * MiB, W_INCD = 0, W_GATE = 5 * MiB, W_OUT = 8 * MiB, W_UP = 10 * MiB, W_DOWN = 21 * MiB;
constexpr size_t WS_H = 28 * MiB, WS_AR = 60 * MiB, WS_MISC = 236 * MiB, WS_NEED = 238 * MiB, M_ST = WS_MISC + 1536 * 1024;
constexpr size_t A_U = WS_AR, A_A2 = WS_AR + 88 * MiB, A_Y = WS_AR;
constexpr size_t A_AB = WS_AR, A_E = WS_AR + 32 * MiB, A_Q = WS_AR + 64 * MiB, A_KP = WS_AR + 80 * MiB, A_KS = WS_AR + 88 * MiB,
                 A_VTP = WS_AR + 98 * MiB, A_VTS = WS_AR + 106 * MiB, A_HCAT = WS_AR + 116 * MiB, A_WB = WS_AR + 120 * MiB, A_YS = WS_AR + 128 * MiB;
constexpr size_t A_XIN = WS_AR, A_BG = WS_AR + 16 * MiB, A_CG = WS_AR + 32 * MiB, A_XR = WS_AR + 48 * MiB, A_GB = WS_AR + 64 * MiB,
                 A_XC = WS_AR + 80 * MiB, A_HF = WS_AR + 96 * MiB, A_LA = WS_AR, A_BV = WS_AR + 32 * MiB;
constexpr size_t M_MOD = WS_MISC, M_ROPE = WS_MISC + 256 * 1024, M_SCAL = WS_MISC + 768 * 1024, M_SP8 = WS_MISC + 772 * 1024;
constexpr size_t O_K = 16777216, O_V = 20971520, O_S5 = 25165824, O_LRU = 25427968;

struct Params { const float* in[37]; float* out; unsigned char* ws; };
constexpr size_t WS_MISC_ = 236ull << 20;
constexpr int TAB_OFF = 143360;
struct Ctx { const LAS unsigned long long* tab;
    __device__ __forceinline__ unsigned long long ld(int i) const {
        const unsigned long long v = tab[i];
        const unsigned lo = __builtin_amdgcn_readfirstlane((unsigned)v), hi = __builtin_amdgcn_readfirstlane((unsigned)(v >> 32));
        return ((unsigned long long)hi << 32) | lo; }
    __device__ __forceinline__ const float* in(int i) const { return (const float*)(const __attribute__((address_space(1))) float*)ld(i); }
    __device__ __forceinline__ float* out() const { return (float*)(__attribute__((address_space(1))) float*)ld(37); }
    __device__ __forceinline__ unsigned char* ws() const { return (unsigned char*)(__attribute__((address_space(1))) unsigned char*)ld(38); }
    __device__ __forceinline__ unsigned* xbarp() const { return (unsigned*)(__attribute__((address_space(1))) unsigned char*)ld(38) + (WS_MISC_ + 900 * 1024) / 4; }
    __device__ __forceinline__ unsigned* barp() const { return (unsigned*)(__attribute__((address_space(1))) unsigned char*)ld(38) + (WS_MISC_ + 800 * 1024) / 4; } };
__device__ __forceinline__ int otid() { int t = threadIdx.x; asm volatile("" : "+v"(t)); return t; }

__device__ __forceinline__ unsigned cvt_pk_bf16(float lo, float hi) { unsigned r; asm("v_cvt_pk_bf16_f32 %0, %1, %2" : "=v"(r) : "v"(lo), "v"(hi)); return r; }
__device__ __forceinline__ bf16_t f2bf(float f) { return (bf16_t)(cvt_pk_bf16(f, 0.f) & 0xffffu); }
__device__ __forceinline__ float bf2f(bf16_t b) { return __uint_as_float(((unsigned)b) << 16); }
__device__ __forceinline__ float bflo(unsigned w) { return __uint_as_float(w << 16); }
__device__ __forceinline__ float bfhi(unsigned w) { return __uint_as_float(w & 0xffff0000u); }
__device__ __forceinline__ float sigmoidf_(float x) { return __builtin_amdgcn_rcpf(1.0f + __builtin_amdgcn_exp2f(-1.4426950408889634f * x)); }
__device__ __forceinline__ float gelu_t(float x) { const float z = -2.302208198f * (x + 0.044715f * x * x * x); return x * __builtin_amdgcn_rcpf(1.0f + __builtin_amdgcn_exp2f(z)); }
__device__ __forceinline__ float wave_sum(float v) { for (int o = 32; o >= 1; o >>= 1) v += __shfl_xor(v, o); return v; }
__device__ __forceinline__ void unpack8(const u32x4 w, float (&v)[8]) { v[0] = bflo(w.x); v[1] = bfhi(w.x); v[2] = bflo(w.y); v[3] = bfhi(w.y); v[4] = bflo(w.z); v[5] = bfhi(w.z); v[6] = bflo(w.w); v[7] = bfhi(w.w); }

namespace pg8 {
constexpr int BM = 256, BK = 64, HALF = 128, HTB = HALF * BK * 2, NXCD = 8, WGM = 8;
__device__ __forceinline__ int lds_byte(int r, int c) { const int st = (r >> 4) * 2 + (c >> 5), rr = r & 15, cc = c & 31, ob = rr * 64 + cc * 2; return st * 1024 + (ob ^ (((ob >> 9) & 1) << 5)); }
__device__ __forceinline__ void stage_rc(int b, int& R, int& C) { const int st = b / 1024, sb = b % 1024, swz = sb ^ (((sb >> 9) & 1) << 5); R = (st >> 1) * 16 + swz / 64; C = (st & 1) * 32 + (swz % 64) / 2; }
__device__ __forceinline__ int perm32(int rho) { const int n = rho >> 4, i = rho & 15; return 8 * (i >> 2) + 4 * n + (i & 3); }
struct Unit { int pm, pn; };
struct Gemm { const bf16_t* A; const bf16_t* Bt; int lda, ldb, K; };
struct StaticOrder {
    int nM, nN, nwg, G, c;
    __device__ void init(int M, int N, int G_, int c_) { nM = M / BM; nN = N / BM; nwg = nM * nN; G = G_; c = c_; }
    __device__ bool next(int i, Unit& u) const {
        const long L = (long)i * G + c; if (L >= nwg) return false;
        int wgid = (int)L; { const int q = nwg / NXCD, r = nwg % NXCD, xcd = wgid % NXCD, off = wgid / NXCD; wgid = (xcd < r ? xcd * (q + 1) : r * (q + 1) + (xcd - r) * q) + off; }
        const int nig = WGM * nN, gid = wgid / nig, fm = gid * WGM, gsz = (nM - fm) < WGM ? (nM - fm) : WGM;
        u.pm = fm + ((wgid % nig) % gsz); u.pn = (wgid % nig) / gsz; return true;
    }
    __device__ __forceinline__ size_t aoff(const Unit& u, size_t tstepA, int lda) const { return (size_t)u.pm * tstepA; }
    __device__ __forceinline__ size_t boff(const Unit& u, size_t tstepB) const { return (size_t)u.pn * tstepB; }
};
struct GateOrder : StaticOrder {
    __device__ __forceinline__ size_t aoff(const Unit& u, size_t tstepA, int lda) const { return (size_t)u.pm * tstepA + (size_t)(((u.pn & 3) >> 1) * 256) * 2; }
    __device__ __forceinline__ size_t boff(const Unit& u, size_t tstepB) const { return (size_t)u.pn * tstepB + (size_t)(((u.pn & 3) >> 1) * 256) * 2; }
};
struct FfnOrder : StaticOrder {
    __device__ void init2(int G_, int c_) { nM = 68; nN = 22; nwg = 68 * 22; G = G_; c = c_; }
    __device__ __forceinline__ size_t aoff(const Unit& u, size_t tstepA, int lda) const {
        const int q = u.pm - 32; const int sb = q / 9, k = q - 9 * sb;
        const long tok = u.pm < 32 ? 256 * u.pm : 8192 + 2048 * sb + 254 * k - 1;
        return (size_t)(tok * lda * 2); }
};
struct S5Order {
    int G, c;
    __device__ bool next(int i, Unit& u) const { const int L = i * G + c; if (L >= 128) return false; u.pm = L; u.pn = L >> 2; return true; }
    __device__ __forceinline__ size_t aoff(const Unit& u, size_t tstepA, int lda) const { return (size_t)u.pm * tstepA; }
    __device__ __forceinline__ size_t boff(const Unit& u, size_t tstepB) const { return (size_t)u.pn * tstepB; }
};

template <class Epi, class Sched>
__device__ __forceinline__ void gemm_phase(LAS unsigned char* lds, const Gemm g, const Sched& S, const Epi& E) {
    int tid_ = threadIdx.x; asm volatile("" : "+v"(tid_));
    const int tid = tid_, wid = __builtin_amdgcn_readfirstlane(tid >> 6), lane = tid & 63, wr = wid >> 2, wc = wid & 3, fr = lane & 15, fq = lane >> 4;
    const int K = g.K, nt = K / BK;
    unsigned voffA[2], voffB[2];
#pragma unroll
    for (int i = 0; i < 2; ++i) { int R, C; stage_rc(tid * 16 + i * 8192, R, C); const int Rb = Epi::PERM ? ((R & ~31) + perm32(R & 31)) : R;
        const int Ra = Epi::ROWPERM ? (128 * (R >> 6) + 8 * (R & 15) + ((R >> 4) & 3)) : R;
        voffA[i] = (unsigned)(Ra * g.lda + C) * 2u; voffB[i] = (unsigned)(Rb * g.ldb + C) * 2u; }
    const size_t kstep = (size_t)(BK * 2);
    const size_t hstepA = Epi::ROWPERM ? (size_t)4 * g.lda * 2 : (size_t)HALF * g.lda * 2, hstepB = (size_t)HALF * g.ldb * 2;
    const size_t tstepA = (size_t)BM * g.lda * 2, tstepB = 2 * hstepB;
    const unsigned ldsw = (unsigned)wid * 1024u;
    const int aoff = lds_byte(wr * 64 + fr, fq * 8), boff = lds_byte(wc * 32 + fr, fq * 8);
#define PG8_SA(b, h) (((b) * 2 + (h)) * HTB)
#define PG8_SB(b, h) ((4 + (b) * 2 + (h)) * HTB)
#define PG8_STAGE(bufoff, gbase, voff) do { _Pragma("unroll") for (int _i = 0; _i < 2; ++_i) \
        __builtin_amdgcn_global_load_lds((const unsigned*)((const char*)(gbase) + (voff)[_i]), (LAS unsigned*)(lds + (bufoff) + ldsw + _i * 8192), 16, 0, 0); } while (0)
#define PG8_LDA(dst, b, h) do { _Pragma("unroll") for (int m = 0; m < 4; ++m) _Pragma("unroll") for (int k = 0; k < 2; ++k) dst[m][k] = *(const LAS bf16x8*)(lds + PG8_SA(b, h) + aoff + m * 2048 + k * 1024); } while (0)
#define PG8_LDB(dst, b, h) do { _Pragma("unroll") for (int n = 0; n < 2; ++n) _Pragma("unroll") for (int k = 0; k < 2; ++k) dst[n][k] = *(const LAS bf16x8*)(lds + PG8_SB(b, h) + boff + n * 2048 + k * 1024); } while (0)
#define PG8_MMA(ai, bj, At, Bt) do { __builtin_amdgcn_s_setprio(1); _Pragma("unroll") for (int m = 0; m < 4; ++m) _Pragma("unroll") for (int n = 0; n < 2; ++n) _Pragma("unroll") for (int k = 0; k < 2; ++k) \
        acc[ai][bj][m][n] = __builtin_amdgcn_mfma_f32_16x16x32_bf16(Bt[n][k], At[m][k], acc[ai][bj][m][n], 0, 0, 0); __builtin_amdgcn_s_setprio(0); } while (0)
#define PG8_WAIT_V(n) asm volatile("s_waitcnt vmcnt(" #n ")" ::: "memory")
#define PG8_WAIT_L(n) asm volatile("s_waitcnt lgkmcnt(" #n ")" ::: "memory")
#define PG8_BAR __builtin_amdgcn_s_barrier()
#define PG8_SCHED __builtin_amdgcn_sched_barrier(0)
    Unit cur, nxt; int ui = 0;
    if (!S.next(0, cur)) return;
    f32x4 acc[2][2][4][2];
#pragma unroll
    for (int a = 0; a < 2; ++a)
#pragma unroll
        for (int b = 0; b < 2; ++b)
#pragma unroll
            for (int m = 0; m < 4; ++m)
#pragma unroll
                for (int n = 0; n < 2; ++n) acc[a][b][m][n] = (f32x4){0.f, 0.f, 0.f, 0.f};
    bf16x8 At[4][2], B0[2][2], B1[2][2];
    const char* cA = (const char*)g.A + S.aoff(cur, tstepA, g.lda); const char* cB = (const char*)g.Bt + S.boff(cur, tstepB);
    PG8_STAGE(PG8_SB(0, 0), cB, voffB); PG8_STAGE(PG8_SA(0, 0), cA, voffA); PG8_STAGE(PG8_SB(0, 1), cB + hstepB, voffB); PG8_STAGE(PG8_SA(0, 1), cA + hstepA, voffA);
    if (wr == 1) PG8_BAR;
    PG8_WAIT_V(4); PG8_BAR;
    PG8_STAGE(PG8_SB(1, 0), cB + kstep, voffB); PG8_STAGE(PG8_SA(1, 0), cA + kstep, voffA); PG8_STAGE(PG8_SB(1, 1), cB + hstepB + kstep, voffB);
    PG8_WAIT_V(6); PG8_BAR;
    for (;;) {
        const bool has_next = S.next(ui + 1, nxt);
        const char* nA = has_next ? (const char*)g.A + S.aoff(nxt, tstepA, g.lda) : cA; const char* nB = has_next ? (const char*)g.Bt + S.boff(nxt, tstepB) : cB;
        for (int t = 0; t < nt; t += 2) {
            const bool last = (t == nt - 2);
            const char* a1 = cA + (size_t)(t + 1) * kstep;
            const char* a2 = last ? nA : cA + (size_t)(t + 2) * kstep; const char* b2 = last ? nB : cB + (size_t)(t + 2) * kstep;
            const char* a3 = a2 + kstep; const char* b3 = b2 + kstep;
            PG8_LDB(B0, 0, 0); PG8_SCHED; PG8_LDA(At, 0, 0); PG8_STAGE(PG8_SA(1, 1), a1 + hstepA, voffA);
            PG8_WAIT_L(8); PG8_BAR; PG8_WAIT_L(0); PG8_MMA(0, 0, At, B0); PG8_BAR; PG8_SCHED;
            PG8_LDB(B1, 0, 1); PG8_STAGE(PG8_SB(0, 0), b2, voffB);
            PG8_BAR; PG8_WAIT_L(0); PG8_MMA(0, 1, At, B1); PG8_BAR;
            PG8_LDA(At, 0, 1); PG8_STAGE(PG8_SA(0, 0), a2, voffA);
            PG8_BAR; PG8_WAIT_L(0); PG8_MMA(1, 0, At, B0); PG8_BAR; PG8_SCHED;
            PG8_STAGE(PG8_SB(0, 1), b2 + hstepB, voffB);
            PG8_WAIT_V(6); PG8_BAR; PG8_MMA(1, 1, At, B1); PG8_BAR;
            PG8_LDB(B0, 1, 0); PG8_SCHED; PG8_LDA(At, 1, 0); PG8_STAGE(PG8_SA(0, 1), a2 + hstepA, voffA);
            PG8_WAIT_L(8); PG8_BAR; PG8_WAIT_L(0); PG8_MMA(0, 0, At, B0); PG8_BAR; PG8_SCHED;
            PG8_LDB(B1, 1, 1); PG8_STAGE(PG8_SB(1, 0), b3, voffB);
            PG8_BAR; PG8_WAIT_L(0); PG8_MMA(0, 1, At, B1); PG8_BAR;
            PG8_LDA(At, 1, 1); PG8_STAGE(PG8_SA(1, 0), a3, voffA);
            PG8_BAR; PG8_WAIT_L(0); PG8_MMA(1, 0, At, B0); PG8_BAR; PG8_SCHED;
            PG8_STAGE(PG8_SB(1, 1), b3 + hstepB, voffB);
            PG8_WAIT_V(6); PG8_BAR; PG8_MMA(1, 1, At, B1); PG8_BAR;
        }
        if constexpr (Epi::AFTER_DRAIN) {} else if constexpr (Epi::ROWPERM) E.fused(acc, cur, wr, wc, fr, fq, lds); else E(acc, cur, wr, wc, fr, fq);
        if (!has_next) break;
#pragma unroll
        for (int a = 0; a < 2; ++a)
#pragma unroll
            for (int b = 0; b < 2; ++b)
#pragma unroll
                for (int m = 0; m < 4; ++m)
#pragma unroll
                    for (int n = 0; n < 2; ++n) acc[a][b][m][n] = (f32x4){0.f, 0.f, 0.f, 0.f};
        cur = nxt; cA = nA; cB = nB; ++ui;
    }
    PG8_WAIT_V(0);
    if (wr == 0) PG8_BAR;
    PG8_BAR;
    if constexpr (Epi::AFTER_DRAIN) E.drain(acc, cur, wr, wc, fr, fq, lds);
#undef PG8_SA
#undef PG8_SB
#undef PG8_STAGE
#undef PG8_LDA
#undef PG8_LDB
#undef PG8_MMA
#undef PG8_WAIT_V
#undef PG8_WAIT_L
#undef PG8_BAR
#undef PG8_SCHED
}

typedef const f32x4 (&AccT)[2][2][4][2];

template <bool NOPN> struct EpiF32 {
    static constexpr bool PERM = false, ROWPERM = false, AFTER_DRAIN = false;
    float* C; int ldc;
    __device__ __forceinline__ void operator()(AccT acc, const Unit& u, int wr, int wc, int fr, int fq) const {
        const int row0 = u.pm * BM + wr * 64 + fr, col0 = (NOPN ? 0 : u.pn * BM) + wc * 32 + 4 * fq;
#pragma unroll
        for (int ai = 0; ai < 2; ++ai)
#pragma unroll
            for (int m = 0; m < 4; ++m) { float* rowp = C + (size_t)(row0 + ai * HALF + m * 16) * ldc + col0;
#pragma unroll
                for (int bj = 0; bj < 2; ++bj)
#pragma unroll
                    for (int n = 0; n < 2; ++n) *(f32x4*)(rowp + bj * HALF + n * 16) = acc[ai][bj][m][n]; }
    }
};
struct EpiBf16 {
    static constexpr bool PERM = true, ROWPERM = false, AFTER_DRAIN = false;
    bf16_t* O; int ldc; int tpb; size_t bufstride;
    __device__ __forceinline__ void operator()(AccT acc, const Unit& u, int wr, int wc, int fr, int fq) const {
        const int row0 = u.pm * BM + wr * 64 + fr; const int bsel = u.pn / tpb; const int col0 = (u.pn - bsel * tpb) * BM + wc * 32 + 8 * fq;
        bf16_t* base = O + (size_t)bsel * bufstride;
#pragma unroll
        for (int ai = 0; ai < 2; ++ai)
#pragma unroll
            for (int m = 0; m < 4; ++m) { bf16_t* rowp = base + (size_t)(row0 + ai * HALF + m * 16) * ldc + col0;
#pragma unroll
                for (int bj = 0; bj < 2; ++bj) { const f32x4 v0 = acc[ai][bj][m][0], v1 = acc[ai][bj][m][1];
                    u32x4 w; w.x = cvt_pk_bf16(v0[0], v0[1]); w.y = cvt_pk_bf16(v0[2], v0[3]); w.z = cvt_pk_bf16(v1[0], v1[1]); w.w = cvt_pk_bf16(v1[2], v1[3]);
                    *(u32x4*)(rowp + bj * HALF) = w; } }
    }
};
struct EpiInAB {
    static constexpr bool PERM = false, ROWPERM = false, AFTER_DRAIN = false;
    bf16_t *AB, *Q, *KP, *KS, *VTP, *VTS; float *outK, *outV; const f32x2* rope;
    __device__ __forceinline__ void operator()(AccT acc, const Unit& u, int wr, int wc, int fr, int fq) const {
        const int sec = u.pn >> 1;
        const int cbase = (u.pn & 1) * 256 + wc * 32 + 4 * fq;
        const bool samp = u.pm >= 32;
#pragma unroll
        for (int ai = 0; ai < 2; ++ai)
#pragma unroll
            for (int m = 0; m < 4; ++m) {
                const int row = u.pm * BM + ai * HALF + wr * 64 + m * 16 + fr;
                if (sec == 0) {
                    const int j = row >> 4, s = row & 15;
#pragma unroll
                    for (int bj = 0; bj < 2; ++bj)
#pragma unroll
                        for (int n = 0; n < 2; ++n) { const int c = cbase + bj * HALF + n * 16; const int g = c >> 4, q0 = c & 15; const f32x4 v = acc[ai][bj][m][n];
                            u32x2 w; w.x = cvt_pk_bf16(v[0], v[1]); w.y = cvt_pk_bf16(v[2], v[3]);
                            *(u32x2*)(AB + ((size_t)(g * 1024 + j) * 512 + s * 16 + q0)) = w; }
                } else if (sec == 3) {
                    const int b = samp ? ((row - NPROMPT) >> 11) : (row >> 8); const int t = samp ? ((row - NPROMPT) & 2047) : (row & 255);
                    const int Lk = samp ? 2560 : 256; bf16_t* vt = samp ? VTS : VTP;
#pragma unroll
                    for (int bj = 0; bj < 2; ++bj)
#pragma unroll
                        for (int n = 0; n < 2; ++n) { const int c = cbase + bj * HALF + n * 16; const f32x4 v = acc[ai][bj][m][n];
                            if (!samp) *(f32x4*)(outV + (size_t)row * 512 + c) = v;
                            const int h = c >> 7, dv = c & 127; bf16_t* dst = vt + ((size_t)((b * 4 + h) * 128 + dv)) * Lk + t;
                            dst[0] = f2bf(v[0]); dst[Lk] = f2bf(v[1]); dst[2 * Lk] = f2bf(v[2]); dst[3 * Lk] = f2bf(v[3]); }
                } else {
                    const int t = (row - NPROMPT) & 2047; const int sb = (row - NPROMPT) >> 11;
#pragma unroll
                    for (int bj = 0; bj < 2; ++bj) {
                        f32x4 v0 = acc[ai][bj][m][0], v1 = acc[ai][bj][m][1];
                        const int c = cbase + bj * HALF;
                        if (samp) {
                            const f32x2* rp = rope + ((size_t)(t * 2 + (wc & 1)) * 16 + 4 * fq);
                            const f32x4 r01 = *(const f32x4*)rp, r23 = *(const f32x4*)(rp + 2);
                            const float cs[4] = {r01[0], r01[2], r23[0], r23[2]}, sn[4] = {r01[1], r01[3], r23[1], r23[3]};
                            f32x4 o0, o1;
#pragma unroll
                            for (int i = 0; i < 4; ++i) { o0[i] = v0[i] * cs[i] - v1[i] * sn[i]; o1[i] = v1[i] * cs[i] + v0[i] * sn[i]; }
                            v0 = o0; v1 = o1;
                        }
                        u32x2 w0, w1; w0.x = cvt_pk_bf16(v0[0], v0[1]); w0.y = cvt_pk_bf16(v0[2], v0[3]); w1.x = cvt_pk_bf16(v1[0], v1[1]); w1.y = cvt_pk_bf16(v1[2], v1[3]);
                        if (sec == 1) { bf16_t* dst = Q + (size_t)row * 512 + c; *(u32x2*)dst = w0; *(u32x2*)(dst + 16) = w1; }
                        else if (!samp) { float* ok = outK + (size_t)row * 512 + c; *(f32x4*)ok = v0; *(f32x4*)(ok + 16) = v1;
                            bf16_t* dst = KP + (size_t)row * 512 + c; *(u32x2*)dst = w0; *(u32x2*)(dst + 16) = w1; }
                        else { bf16_t* dst = KS + ((size_t)(sb * 2560 + t)) * 512 + c; *(u32x2*)dst = w0; *(u32x2*)(dst + 16) = w1; }
                    }
                }
            }
    }
};
struct EpiS5B {
    static constexpr bool PERM = false, ROWPERM = false, AFTER_DRAIN = false;
    bf16_t* YS;
    __device__ __forceinline__ void operator()(AccT acc, const Unit& u, int wr, int wc, int fr, int fq) const {
        const int g = u.pn;
#pragma unroll
        for (int ai = 0; ai < 2; ++ai)
#pragma unroll
            for (int m = 0; m < 4; ++m) { const int j = (u.pm & 3) * BM + ai * HALF + wr * 64 + m * 16 + fr;
#pragma unroll
                for (int bj = 0; bj < 2; ++bj)
#pragma unroll
                    for (int n = 0; n < 2; ++n) { const int t = 8 * bj + 2 * wc + n; const f32x4 v = acc[ai][bj][m][n];
                        u32x2 w; w.x = cvt_pk_bf16(gelu_t(v[0]), gelu_t(v[1])); w.y = cvt_pk_bf16(gelu_t(v[2]), gelu_t(v[3]));
                        *(u32x2*)(YS + (size_t)(16 * j + t) * 512 + 16 * g + 4 * fq) = w; } }
    }
};
struct EpiGLU {
    static constexpr bool PERM = true, ROWPERM = false, AFTER_DRAIN = false;
    const bf16_t* YS; bf16_t* CAT; const float* bias;
    __device__ __forceinline__ void operator()(AccT acc, const Unit& u, int wr, int wc, int fr, int fq) const {
        const int row0 = u.pm * BM + wr * 64 + fr, col0 = u.pn * BM + wc * 32 + 8 * fq;
        f32x4 b0[2], b1[2];
#pragma unroll
        for (int bj = 0; bj < 2; ++bj) { const int c = col0 + bj * HALF; b0[bj] = *(const f32x4*)(bias + c); b1[bj] = *(const f32x4*)(bias + c + 4); }
#pragma unroll
        for (int ai = 0; ai < 2; ++ai) {
            u32x4 yw[1][4][2];
#pragma unroll
            for (int bj = 0; bj < 2; ++bj)
#pragma unroll
                for (int m = 0; m < 4; ++m) yw[0][m][bj] = *(const u32x4*)(YS + (size_t)(row0 + ai * HALF + m * 16) * 512 + col0 + bj * HALF);
#pragma unroll
            for (int m = 0; m < 4; ++m) { const int row = row0 + ai * HALF + m * 16;
#pragma unroll
                for (int bj = 0; bj < 2; ++bj) { const int c = col0 + bj * HALF;
                    float y[8]; unpack8(yw[0][m][bj], y);
                    const f32x4 v0 = acc[ai][bj][m][0] + b0[bj], v1 = acc[ai][bj][m][1] + b1[bj];
                    float o[8];
#pragma unroll
                    for (int i = 0; i < 4; ++i) { o[i] = y[i] * sigmoidf_(v0[i]); o[4 + i] = y[4 + i] * sigmoidf_(v1[i]); }
                    u32x4 w; w.x = cvt_pk_bf16(o[0], o[1]); w.y = cvt_pk_bf16(o[2], o[3]); w.z = cvt_pk_bf16(o[4], o[5]); w.w = cvt_pk_bf16(o[6], o[7]);
                    *(u32x4*)(CAT + (size_t)row * 1024 + c) = w; } }
            asm volatile("" ::: "memory"); }
    }
};
struct EpiGate {
    static constexpr bool PERM = false, ROWPERM = false, AFTER_DRAIN = false;
    const bf16_t* XC; bf16_t *LA, *BV; const float *ba, *bx, *sp8;
    __device__ __forceinline__ void operator()(AccT acc, const Unit& u, int wr, int wc, int fr, int fq) const {
        const int d = u.pn >> 2;
#pragma unroll
        for (int bj = 0; bj < 2; ++bj) { const int ch = 16 * (8 * (u.pn & 3) + 4 * bj + wc) + 4 * fq;
            const f32x4 va = *(const f32x4*)(ba + d * 512 + ch), vx = *(const f32x4*)(bx + d * 512 + ch), vs = *(const f32x4*)(sp8 + d * 512 + ch);
#pragma unroll
            for (int ai = 0; ai < 2; ++ai) {
                u32x2 xw[4];
#pragma unroll
                for (int m = 0; m < 4; ++m) { const int row = u.pm * BM + ai * HALF + wr * 64 + m * 16 + fr; xw[m] = *(const u32x2*)(XC + (size_t)row * 512 + ch); }
#pragma unroll
                for (int m = 0; m < 4; ++m) { const int row = u.pm * BM + ai * HALF + wr * 64 + m * 16 + fr;
                    const float xc[4] = {bflo(xw[m].x), bfhi(xw[m].x), bflo(xw[m].y), bfhi(xw[m].y)};
                    const f32x4 pr = acc[ai][bj][m][0] + va, pi = acc[ai][bj][m][1] + vx;
                    float la[4], bv[4];
#pragma unroll
                    for (int i = 0; i < 4; ++i) { const float r = sigmoidf_(pr[i]), ig = sigmoidf_(pi[i]); la[i] = -r * vs[i];
                        const float om = fmaxf(1.0f - __builtin_amdgcn_exp2f(2.885390082f * la[i]), 0.f);
                        bv[i] = __builtin_amdgcn_sqrtf(om) * (ig * xc[i]); }
                    u32x2 wl, wb; wl.x = cvt_pk_bf16(la[0], la[1]); wl.y = cvt_pk_bf16(la[2], la[3]); wb.x = cvt_pk_bf16(bv[0], bv[1]); wb.y = cvt_pk_bf16(bv[2], bv[3]);
                    const size_t off = ((size_t)d * NTOK + row) * 512 + ch;
                    *(u32x2*)(LA + off) = wl; *(u32x2*)(BV + off) = wb; }
                asm volatile("" ::: "memory"); } }
    }
};
__device__ __forceinline__ float dpp_shr1(float v) { return __builtin_bit_cast(float, __builtin_amdgcn_update_dpp(0, __builtin_bit_cast(int, v), 0x111, 0xf, 0xf, true)); }
__device__ __forceinline__ float dpp_shl1(float v) { return __builtin_bit_cast(float, __builtin_amdgcn_update_dpp(0, __builtin_bit_cast(int, v), 0x101, 0xf, 0xf, true)); }
struct EpiFfnUp {
    static constexpr bool PERM = false, ROWPERM = true, AFTER_DRAIN = false;
    bf16_t* A2; const float* cw; const float* cb;
    __device__ __forceinline__ void fused(f32x4 (&acc)[2][2][4][2], const Unit& u, int wr, int wc, int fr, int fq, LAS unsigned char* lds) const {
        LAS float* xch = (LAS float*)(lds + 131072);
        if ((wr == 0) ? (fr == 15) : (fr == 0)) { LAS float* dst = xch + ((wc * 2 + wr) * 4 + fq) * 16;
#pragma unroll
            for (int bj = 0; bj < 2; ++bj)
#pragma unroll
                for (int n = 0; n < 2; ++n) *(LAS f32x4*)(dst + (bj * 2 + n) * 4) = (wr == 0) ? acc[1][bj][3][n] : acc[0][bj][0][n]; }
        asm volatile("s_waitcnt lgkmcnt(0)" ::: "memory"); __builtin_amdgcn_s_barrier(); asm volatile("" ::: "memory");
        if (wr == 0) { __builtin_amdgcn_s_barrier(); asm volatile("" ::: "memory"); }
        const LAS float* xsp = xch + ((wc * 2 + (1 - wr)) * 4 + fq) * 16;
        const bool samp = u.pm >= 32; const int q = u.pm - 32; const int sb = q / 9, k = q - 9 * sb;
        const int tstart = samp ? 254 * k - 1 : 0, L = samp ? 2048 : 256, olo = samp ? 1 : 0, ohi = samp ? 254 : 255;
        const size_t rowbase = samp ? (size_t)(8192 + 2048 * sb) : (size_t)(256 * u.pm);
        const int o0 = 128 * wr + 8 * fr;
        const int cch0 = 128 * u.pn + 32 * wc + 4 * fq;
        const f32x4 z = (f32x4){0.f, 0.f, 0.f, 0.f};
#pragma unroll
        for (int n = 0; n < 2; ++n) {
            const int cch = cch0 + 16 * n;
#pragma unroll
            for (int bj = 0; bj < 2; ++bj) {
                const float* wp = cw + bj * 2816 + cch;
                const f32x4 w0 = *(const f32x4*)wp, w1 = *(const f32x4*)(wp + 5632), w2 = *(const f32x4*)(wp + 2 * 5632), bb = *(const f32x4*)(cb + bj * 2816 + cch);
                f32x4 prev, nx;
#pragma unroll
                for (int i = 0; i < 4; ++i) { prev[i] = dpp_shr1(acc[1][bj][3][n][i]); nx[i] = dpp_shl1(acc[0][bj][0][n][i]); }
                { const f32x4 xp = *(const LAS f32x4*)(xsp + (bj * 2 + n) * 4); if (fr == 0) prev = xp; if (fr == 15) nx = xp; }
#pragma unroll
                for (int e = 0; e < 8; ++e) {
                    const int o = o0 + e, t = tstart + o;
                    const bool lok = t >= 1, rok = t <= L - 2, ook = (o >= olo) && (o <= ohi) && (t >= 0) && (t < L);
                    const f32x4 cur = acc[e >> 2][bj][e & 3][n];
                    const f32x4 nxt = e == 7 ? nx : acc[((e + 1) >> 2) & 1][bj][(e + 1) & 3][n];
                    const f32x4 lft = (e <= 1) ? (lok ? prev : z) : prev, rgt = (e == 0 || e == 7) ? (rok ? nxt : z) : nxt;
                    const f32x4 uu = bb + w0 * lft + w1 * cur + w2 * rgt;
                    prev = cur;
                    if (bj == 0) { const f32x4 zz = uu * (uu * uu * (-0.102943240f) + (-2.302208198f));
                        f32x4 dd; dd[0] = __builtin_amdgcn_exp2f(zz[0]); dd[1] = __builtin_amdgcn_exp2f(zz[1]); dd[2] = __builtin_amdgcn_exp2f(zz[2]); dd[3] = __builtin_amdgcn_exp2f(zz[3]);
                        dd = dd + 1.0f; f32x4 rr; rr[0] = __builtin_amdgcn_rcpf(dd[0]); rr[1] = __builtin_amdgcn_rcpf(dd[1]); rr[2] = __builtin_amdgcn_rcpf(dd[2]); rr[3] = __builtin_amdgcn_rcpf(dd[3]);
                        acc[e >> 2][0][e & 3][n] = uu * rr; }
                    else { const f32x4 gv = acc[e >> 2][0][e & 3][n]; u32x2 pk; pk.x = cvt_pk_bf16(gv[0] * uu[0], gv[1] * uu[1]); pk.y = cvt_pk_bf16(gv[2] * uu[2], gv[3] * uu[3]);
                        if (ook) *(u32x2*)(A2 + (rowbase + t) * 2816 + cch) = pk; }
                }
                __builtin_amdgcn_sched_barrier(0);
            }
        }
        if (wr != 0) { asm volatile("" ::: "memory"); __builtin_amdgcn_s_barrier(); asm volatile("" ::: "memory"); }
    }
};
struct EpiPost {
    static constexpr bool PERM = true, ROWPERM = false, AFTER_DRAIN = true;
    const float *xin0, *xin1; float* X; bf16_t* H; const float* MOD; const float* ng;
    int from_input, lpost, jpost, has_pre, lpre, jpre; float* st; unsigned* cnt; unsigned expect;
    const bf16_t* xb_in; bf16_t* xb_out;
    __device__ __forceinline__ void rowstats(f32x4 (&v)[2][2][4][2], int stage, const Unit& u, int wr, int wc, int fr, int fq, LAS unsigned char* lds) const {
        LAS float* P = (LAS float*)lds; LAS float* S = (LAS float*)(lds + 4096);
        const int tid = otid();
#pragma unroll
        for (int ai = 0; ai < 2; ++ai)
#pragma unroll
            for (int m = 0; m < 4; ++m) { float s = 0.f;
#pragma unroll
                for (int bj = 0; bj < 2; ++bj)
#pragma unroll
                    for (int n = 0; n < 2; ++n) { const f32x4 x = v[ai][bj][m][n]; s += x[0] * x[0] + x[1] * x[1] + x[2] * x[2] + x[3] * x[3]; }
                s += __shfl_xor(s, 16); s += __shfl_xor(s, 32);
                if (fq == 0) P[(ai * HALF + wr * 64 + m * 16 + fr) * 4 + wc] = s; }
        __syncthreads();
        float* slot = st + ((size_t)(stage * NTOK + u.pm * BM)) * 4;
        if (tid < 256) { const float s = P[tid * 4] + P[tid * 4 + 1] + P[tid * 4 + 2] + P[tid * 4 + 3];
            __hip_atomic_store(slot + tid * 4 + u.pn, s, __ATOMIC_RELAXED, __HIP_MEMORY_SCOPE_AGENT); }
        asm volatile("s_waitcnt vmcnt(0)" ::: "memory");
        __syncthreads();
        if (tid == 0) { unsigned* c = cnt + (stage * 64 + u.pm) * 64;
            __hip_atomic_fetch_add(c, 1u, __ATOMIC_RELAXED, __HIP_MEMORY_SCOPE_AGENT);
            unsigned spins = 0;
            while (__hip_atomic_load(c, __ATOMIC_RELAXED, __HIP_MEMORY_SCOPE_AGENT) < expect && ++spins < (1u << 22)) __builtin_amdgcn_s_sleep(1);
            __builtin_amdgcn_fence(__ATOMIC_ACQUIRE, "agent");
            asm volatile("s_waitcnt vmcnt(0)" ::: "memory"); }
        __syncthreads();
        if (tid < 256) { float s = 0.f;
#pragma unroll
            for (int t = 0; t < 4; ++t) s += __hip_atomic_load(slot + tid * 4 + t, __ATOMIC_RELAXED, __HIP_MEMORY_SCOPE_AGENT);
            S[tid] = rsqrtf(s * (1.0f / 1024.0f) + 1e-6f); }
        __syncthreads();
    }
    __device__ __forceinline__ void drain(f32x4 (&acc)[2][2][4][2], const Unit& u, int wr, int wc, int fr, int fq, LAS unsigned char* lds) const {
        const LAS float* S = (const LAS float*)(lds + 4096);
        const int cv = u.pm < 32 ? 0 : 1 + ((u.pm - 32) >> 3);
        const int col0 = u.pn * BM + wc * 32 + 8 * fq;
        rowstats(acc, 0, u, wr, wc, fr, fq, lds);
        { const float* gp = ng + (lpost * 4 + (jpost ? 3 : 1)) * 1024 + col0; const float* gate = MOD + ((size_t)(lpost * 5 + cv) * 6 + 3 * jpost + 2) * 1024 + col0;
          f32x4 gg[2][2];
#pragma unroll
          for (int bj = 0; bj < 2; ++bj)
#pragma unroll
              for (int n = 0; n < 2; ++n) gg[bj][n] = *(const f32x4*)(gate + bj * HALF + 4 * n) * *(const f32x4*)(gp + bj * HALF + 4 * n);
          u32x4 xqa[2][4][2];
          if (!from_input) {
#pragma unroll
              for (int ai = 0; ai < 2; ++ai)
#pragma unroll
                  for (int m = 0; m < 4; ++m) { const int row = u.pm * BM + ai * HALF + wr * 64 + m * 16 + fr;
#pragma unroll
                      for (int bj = 0; bj < 2; ++bj) xqa[ai][m][bj] = *(const u32x4*)(xb_in + (size_t)row * DM + col0 + bj * HALF); } }
#pragma unroll
          for (int ai = 0; ai < 2; ++ai) {
#pragma unroll
              for (int m = 0; m < 4; ++m) { const int r = ai * HALF + wr * 64 + m * 16 + fr; const int row = u.pm * BM + r; const float rs = S[r];
                  const float* xr = (row < NPROMPT ? xin0 + (size_t)row * DM : xin1 + (size_t)(row - NPROMPT) * DM) + col0;
                  float* xw = X + (size_t)row * DM + col0;
#pragma unroll
                  for (int bj = 0; bj < 2; ++bj) { f32x4 xo0, xo1;
                      if (from_input) { xo0 = *(const f32x4*)(xr + bj * HALF); xo1 = *(const f32x4*)(xr + bj * HALF + 4); }
                      else { float t8[8]; unpack8(xqa[ai][m][bj], t8); xo0 = (f32x4){t8[0], t8[1], t8[2], t8[3]}; xo1 = (f32x4){t8[4], t8[5], t8[6], t8[7]}; }
                      const f32x4 xn0 = xo0 + gg[bj][0] * (acc[ai][bj][m][0] * rs), xn1 = xo1 + gg[bj][1] * (acc[ai][bj][m][1] * rs);
                      acc[ai][bj][m][0] = xn0; acc[ai][bj][m][1] = xn1;
                      if (xb_out) { u32x4 w; w.x = cvt_pk_bf16(xn0[0], xn0[1]); w.y = cvt_pk_bf16(xn0[2], xn0[3]); w.z = cvt_pk_bf16(xn1[0], xn1[1]); w.w = cvt_pk_bf16(xn1[2], xn1[3]);
                          *(u32x4*)(xb_out + (size_t)row * DM + col0 + bj * HALF) = w; }
                      else { *(f32x4*)(xw + bj * HALF) = xn0; *(f32x4*)(xw + bj * HALF + 4) = xn1; } }
                  if (from_input && (m & 1)) asm volatile("" ::: "memory"); }
              asm volatile("" ::: "memory"); } }
        if (has_pre) {
            rowstats(acc, 1, u, wr, wc, fr, fq, lds);
            const float* gq = ng + (lpre * 4 + (jpre ? 2 : 0)) * 1024 + col0; const float* sh = MOD + ((size_t)(lpre * 5 + cv) * 6 + 3 * jpre) * 1024 + col0; const float* sc = sh + 1024;
            f32x4 ga[2][2], sb[2][2];
#pragma unroll
            for (int bj = 0; bj < 2; ++bj)
#pragma unroll
                for (int n = 0; n < 2; ++n) { ga[bj][n] = *(const f32x4*)(gq + bj * HALF + 4 * n) * (1.0f + *(const f32x4*)(sc + bj * HALF + 4 * n)); sb[bj][n] = *(const f32x4*)(sh + bj * HALF + 4 * n); }
#pragma unroll
            for (int ai = 0; ai < 2; ++ai)
#pragma unroll
                for (int m = 0; m < 4; ++m) { const int r = ai * HALF + wr * 64 + m * 16 + fr; const int row = u.pm * BM + r; const float rs = S[r];
                    bf16_t* hw = H + (size_t)row * DM + col0;
#pragma unroll
                    for (int bj = 0; bj < 2; ++bj) { const f32x4 h0 = acc[ai][bj][m][0] * rs * ga[bj][0] + sb[bj][0], h1 = acc[ai][bj][m][1] * rs * ga[bj][1] + sb[bj][1];
                        u32x4 w; w.x = cvt_pk_bf16(h0[0], h0[1]); w.y = cvt_pk_bf16(h0[2], h0[3]); w.z = cvt_pk_bf16(h1[0], h1[1]); w.w = cvt_pk_bf16(h1[2], h1[3]);
                        *(u32x4*)(hw + bj * HALF) = w; } }
        }
        __syncthreads();
    }
};
}

constexpr size_t M_BAR = WS_MISC + 800 * 1024;
__device__ __forceinline__ void gbar(unsigned* bar, unsigned gen, unsigned G, unsigned b) {
    asm volatile("s_waitcnt vmcnt(0) lgkmcnt(0)" ::: "memory");
    __syncthreads();
    if (threadIdx.x == 0) {
        __builtin_amdgcn_fence(__ATOMIC_RELEASE, "agent");
        asm volatile("s_waitcnt vmcnt(0)" ::: "memory");
        const unsigned k = b & 7u, ngrp = G < 8u ? G : 8u, gsize = (G - k + 7u) / 8u;
        const unsigned old = __hip_atomic_fetch_add(bar + k * 64, 1u, __ATOMIC_RELAXED, __HIP_MEMORY_SCOPE_AGENT);
        if (old == gen * gsize - 1u) {
            const unsigned old2 = __hip_atomic_fetch_add(bar + 8 * 64, 1u, __ATOMIC_RELAXED, __HIP_MEMORY_SCOPE_AGENT);
            if (old2 == gen * ngrp - 1u) __hip_atomic_store(bar + 9 * 64, gen, __ATOMIC_RELAXED, __HIP_MEMORY_SCOPE_AGENT);
        }
        while (__hip_atomic_load(bar + 9 * 64, __ATOMIC_RELAXED, __HIP_MEMORY_SCOPE_AGENT) < gen) __builtin_amdgcn_s_sleep(1);
        __builtin_amdgcn_fence(__ATOMIC_ACQUIRE, "agent");
        asm volatile("s_waitcnt vmcnt(0)" ::: "memory");
    }
    __syncthreads();
}

#define XB_TMO      128
#define XB_XCNT(j)  (256  + 64 * (j))
#define XB_XSUB(j)  (1280 + 64 * (j))
#define XB_XGEN(j)  (2304 + 64 * (j))
#define XB_TOP      3328
#define XB_TOPGEN   3392
#define XCD_BAR_WORDS 3456
#define XB_SPIN_CAP (1u << 18)
constexpr size_t M_XBAR = WS_MISC + 900 * 1024;
constexpr int XB_ST_OFF = 143872;
__device__ __forceinline__ unsigned xb_ld(unsigned* p)              { return __hip_atomic_load(p, __ATOMIC_RELAXED, __HIP_MEMORY_SCOPE_AGENT); }
__device__ __forceinline__ unsigned xb_add(unsigned* p, unsigned v) { return __hip_atomic_fetch_add(p, v, __ATOMIC_RELAXED, __HIP_MEMORY_SCOPE_AGENT); }
__device__ __forceinline__ unsigned xb_xcc_id() { return (unsigned)__builtin_amdgcn_s_getreg((3 << 11) | 20) & 0xFu; }
#define XB_SPIN(cond, bar) do { unsigned _sp = 0; while (cond) { __builtin_amdgcn_s_sleep(1); \
    if ((++_sp & 255u) == 0u) { if (xb_ld(&(bar)[XB_TMO])) break; if (_sp > XB_SPIN_CAP) { atomicAdd(&(bar)[XB_TMO], 1u); break; } } } } while (0)
__device__ __forceinline__ void xcd_barrier_complete(unsigned* bar, unsigned x, unsigned& nloc, unsigned& nx, unsigned G) {
    unsigned sum, cnt, mine, sp = 0u;
    for (;;) {
        sum = 0u; cnt = 0u; mine = 0u;
#pragma unroll
        for (unsigned j = 0; j < 16; ++j) { const unsigned c = xb_ld(&bar[XB_XCNT(j)]); sum += c; cnt += (c > 0u) ? 1u : 0u; mine = (j == x) ? c : mine; }
        if (sum == G) break;
        __builtin_amdgcn_s_sleep(1);
        if ((++sp & 255u) == 0u) { if (xb_ld(&bar[XB_TMO])) break; if (sp > XB_SPIN_CAP) { atomicAdd(&bar[XB_TMO], 1u); break; } }
    }
    nloc = mine > 0u ? mine : 1u; nx = cnt > 0u ? cnt : 1u;
}
__device__ __forceinline__ void xcd_barrier(unsigned* bar, volatile LAS unsigned* st, unsigned G) {
    asm volatile("s_waitcnt vmcnt(0) lgkmcnt(0)" ::: "memory");
    __syncthreads();
    if (threadIdx.x == 0) {
        const unsigned x = xb_xcc_id();
        unsigned nloc = st[0], nx = st[1];
        if (nloc == 0u) { xcd_barrier_complete(bar, x, nloc, nx, G); st[0] = nloc; st[1] = nx; }
        const unsigned old = xb_add(&bar[XB_XSUB(x)], 1u);
        const unsigned gen = old / nloc;
        if (old + 1u == (gen + 1u) * nloc) {
            __builtin_amdgcn_fence(__ATOMIC_RELEASE, "agent");
            asm volatile("s_waitcnt vmcnt(0)" ::: "memory");
            const unsigned og = xb_add(&bar[XB_TOP], 1u);
            const unsigned tg = og / nx;
            if (og + 1u == (tg + 1u) * nx) xb_add(&bar[XB_TOPGEN], 1u);
            else XB_SPIN(xb_ld(&bar[XB_TOPGEN]) == tg, bar);
            __builtin_amdgcn_fence(__ATOMIC_ACQUIRE, "agent");
            xb_add(&bar[XB_XGEN(x)], 1u);
            asm volatile("s_waitcnt vmcnt(0)" ::: "memory");
        } else {
            XB_SPIN(xb_ld(&bar[XB_XGEN(x)]) == gen, bar);
            __builtin_amdgcn_fence(__ATOMIC_ACQUIRE, "agent");
            asm volatile("s_waitcnt vmcnt(0)" ::: "memory");
        }
    }
    __syncthreads();
}

__device__ __forceinline__ void transpose_item(const float* W, int K, int N, bf16_t* Wt, int item, LAS float* t, bool upperm = false) {
    const int tid = otid(); const int nbn = N >> 8; const int bn = item % nbn, tk = item / nbn;
    const float* src = W + (size_t)(tk * 64) * N + bn * 256;
    f32x4 v[8];
#pragma unroll
    for (int i = 0; i < 8; ++i) v[i] = *(const f32x4*)(src + (size_t)((tid >> 6) + 8 * i) * N + (tid & 63) * 4);
#pragma unroll
    for (int i = 0; i < 8; ++i) { LAS float* d = t + ((tid >> 6) + 8 * i) * 257 + (tid & 63) * 4; d[0] = v[i][0]; d[1] = v[i][1]; d[2] = v[i][2]; d[3] = v[i][3]; }
    __syncthreads();
#pragma unroll
    for (int j = 0; j < 4; ++j) { const int piece = tid + 512 * j; const int n = piece >> 3, ks = (piece & 7) * 8; float x[8];
#pragma unroll
        for (int q = 0; q < 8; ++q) x[q] = t[(ks + q) * 257 + n];
        u32x4 w; w.x = cvt_pk_bf16(x[0], x[1]); w.y = cvt_pk_bf16(x[2], x[3]); w.z = cvt_pk_bf16(x[4], x[5]); w.w = cvt_pk_bf16(x[6], x[7]);
        int c0 = bn * 256 + (n & ~63); if (upperm) { c0 = c0 < 2816 ? 256 * (c0 >> 7) + (c0 & 127) : 256 * ((c0 - 2816) >> 7) + 128 + ((c0 - 2816) & 127); }
        *(u32x4*)(Wt + (size_t)(c0 + (n & 63)) * K + tk * 64 + ks) = w; }
    __syncthreads();
}
__device__ __forceinline__ void convert_item(const Ctx& p, int layer, int it, LAS float* t) {
    unsigned char* ws = p.ws();
    if (layer == 0) {
        if (it < 128) { transpose_item(p.in(11), 1024, 2048, (bf16_t*)(ws + W_INAB), it, t); return; } it -= 128;
        if (it < 16) { transpose_item(p.in(19), 512, 512, (bf16_t*)(ws + W_GLU), it, t); return; } it -= 16;
        if (it < 64) { transpose_item(p.in(12), 1024, 1024, (bf16_t*)(ws + W_OUT), it, t); return; } it -= 64;
    } else {
        if (it < 160) { transpose_item(p.in(23), 1024, 2560, (bf16_t*)(ws + W_INCD), it, t); return; } it -= 160;
        if (it < 64) { transpose_item(p.in(24), 1024, 1024, (bf16_t*)(ws + W_OUT), it, t); return; } it -= 64;
    }
    if (it < 352) { transpose_item(p.in(33) + (size_t)layer * 1024 * 5632, 1024, 5632, (bf16_t*)(ws + W_UP), it, t, true); return; } it -= 352;
    transpose_item(p.in(36) + (size_t)layer * 2816 * 1024, 2816, 1024, (bf16_t*)(ws + W_DOWN), it, t);
}

__device__ __forceinline__ void mod_item(const Ctx& p, int it, LAS float* sil) {
    const int tid = otid(); const int l = it / 96, cg0 = (it % 96) * 64;
    LAS float* part = sil + 5 * 1024;
    for (int i = tid; i < 5 * 1024; i += 512) { const int c = i >> 10, k = i & 1023; const float v = c == 0 ? p.in(7)[k] : p.in(6)[(c - 1) * 1024 + k]; sil[i] = v / (1.0f + __expf(-v)); }
    __syncthreads();
    const int ks = tid >> 4, c4 = (tid & 15) * 4;
    const float* w = p.in(8) + (size_t)l * 1024 * 6144 + (size_t)(ks * 32) * 6144 + cg0 + c4;
    f32x4 a0 = {0.f, 0.f, 0.f, 0.f}, a1 = a0, a2 = a0, a3 = a0, a4 = a0;
#pragma unroll
    for (int hb = 0; hb < 2; ++hb) { f32x4 wv[16];
#pragma unroll
        for (int k = 0; k < 16; ++k) wv[k] = *(const f32x4*)(w + (size_t)(hb * 16 + k) * 6144);
#pragma unroll
        for (int k = 0; k < 16; ++k) { const int kk = ks * 32 + hb * 16 + k;
            a0 += sil[kk] * wv[k]; a1 += sil[1024 + kk] * wv[k]; a2 += sil[2048 + kk] * wv[k]; a3 += sil[3072 + kk] * wv[k]; a4 += sil[4096 + kk] * wv[k]; } }
#pragma unroll
    for (int j = 0; j < 4; ++j) { part[(ks * 5 + 0) * 64 + c4 + j] = a0[j]; part[(ks * 5 + 1) * 64 + c4 + j] = a1[j]; part[(ks * 5 + 2) * 64 + c4 + j] = a2[j]; part[(ks * 5 + 3) * 64 + c4 + j] = a3[j]; part[(ks * 5 + 4) * 64 + c4 + j] = a4[j]; }
    __syncthreads();
    if (tid < 320) { const int c = tid >> 6, cc = tid & 63; float s = p.in(9)[l * 6144 + cg0 + cc];
        for (int k2 = 0; k2 < 32; ++k2) s += part[(k2 * 5 + c) * 64 + cc];
        ((float*)(p.ws() + M_MOD))[(size_t)(l * 5 + c) * 6144 + cg0 + cc] = s; }
    __syncthreads();
}

__device__ __forceinline__ void s5_build(const Ctx& p, int g, int part, LAS unsigned char* lds) {
    const int tid = otid();
    LAS f32x2* apw = (LAS f32x2*)lds;
    LAS f32x2* Bt = apw + 2 * 64 * 17;
    LAS f32x2* Cc = Bt + 2 * 64 * 16;
    LAS float* Kt = (LAS float*)(Cc + 2 * 16 * 64);
    LAS f32x2* ft = (LAS f32x2*)(Kt + 2 * 16 * 256);
    const float *lam_re = p.in(13), *lam_im = p.in(14), *log_dt = p.in(15), *s5b = p.in(16), *s5c = p.in(17), *s5d = p.in(18);
    if (tid < 128) { const int d = tid >> 6, n = tid & 63; const float dt = expf(log_dt[d * 32 + g]); const float lr = lam_re[(d * 32 + g) * 64 + n], li = lam_im[(d * 32 + g) * 64 + n];
        const float mag = expf(lr * dt); float s, c; sincosf(li * dt, &s, &c); const float ar = mag * c, ai = mag * s;
        float pr = 1.f, pi = 0.f;
        for (int tau = 0; tau <= 16; ++tau) { apw[(d * 64 + n) * 17 + tau] = (f32x2){pr, pi}; const float nr2 = pr * ar - pi * ai, ni2 = pr * ai + pi * ar; pr = nr2; pi = ni2; }
        const float nr = ar - 1.0f, ni = ai, den = lr * lr + li * li;
        ft[d * 64 + n] = (f32x2){(nr * lr + ni * li) / den, (ni * lr - nr * li) / den}; }
    __syncthreads();
    for (int idx = tid; idx < 2048; idx += 512) { const int d = idx >> 10, n = (idx >> 4) & 63, q = idx & 15;
        const float br = s5b[(((size_t)(d * 2 + 0) * 32 + g) * 64 + n) * 16 + q], bi = s5b[(((size_t)(d * 2 + 1) * 32 + g) * 64 + n) * 16 + q]; const f32x2 f = ft[d * 64 + n];
        Bt[idx] = (f32x2){f.x * br - f.y * bi, f.x * bi + f.y * br};
        const int pp = (idx >> 6) & 15, n2 = idx & 63;
        Cc[idx] = (f32x2){s5c[(((size_t)(d * 2 + 0) * 32 + g) * 16 + pp) * 64 + n2], s5c[(((size_t)(d * 2 + 1) * 32 + g) * 16 + pp) * 64 + n2]}; }
    __syncthreads();
    if (part < 2) {
        const int d = tid >> 8, pp = (tid >> 4) & 15, q = tid & 15; float kacc[16];
#pragma unroll
        for (int tau = 0; tau < 16; ++tau) kacc[tau] = 0.f;
        for (int n = 0; n < 64; ++n) { const f32x2 c = Cc[(d * 16 + pp) * 64 + n], b = Bt[(d * 64 + n) * 16 + q], a = apw[(d * 64 + n) * 17 + 1];
            float xr = c.x * b.x - c.y * b.y, xi = c.x * b.y + c.y * b.x;
#pragma unroll
            for (int tau = 0; tau < 16; ++tau) { kacc[tau] += xr; const float nr2 = xr * a.x - xi * a.y, ni2 = xr * a.y + xi * a.x; xr = nr2; xi = ni2; } }
#pragma unroll
        for (int tau = 0; tau < 16; ++tau) Kt[(d * 16 + tau) * 256 + pp * 16 + q] = kacc[tau];
    }
    __syncthreads();
    bf16_t* H = (bf16_t*)(p.ws() + A_HCAT) + (size_t)g * 65536;
    if (part == 2) for (int idx = tid; idx < 65536; idx += 512) { const int row = idx >> 8, col = idx & 255, d = row >> 7, c = (row >> 6) & 1, n = row & 63, s = col >> 4, q = col & 15;
        const f32x2 a = apw[(d * 64 + n) * 17 + (d == 0 ? 15 - s : s)], b = Bt[(d * 64 + n) * 16 + q];
        H[idx] = f2bf(c == 0 ? a.x * b.x - a.y * b.y : a.x * b.y + a.y * b.x); }
    bf16_t* Wb = (bf16_t*)(p.ws() + A_WB) + (size_t)g * 131072;
    if (part != 2) for (int i2 = tid; i2 < 32768; i2 += 512) {
      {
        const int idx = part == 3 ? ((i2 >> 7) << 9) + 256 + ((i2 & 127) << 1) : (((i2 >> 8) + 128 * part) << 9) + (i2 & 255);
       for (int sub = 0; sub < (part == 3 ? 2 : 1); ++sub) {
        const int idx2 = idx + sub;
        const int row = idx2 >> 9, col = idx2 & 511, t = row >> 4, pp = row & 15; float v;
        if (col < 256) { const int s = col >> 4, q = col & 15; v = 0.f;
            if (s <= t) v += Kt[(t - s) * 256 + pp * 16 + q];
            if (s >= t) v += Kt[(16 + s - t) * 256 + pp * 16 + q];
            if (s == t && pp == q) v += s5d[16 * g + pp]; }
        else { const int cc = col - 256, d = cc >> 7, c = (cc >> 6) & 1, n = cc & 63; const f32x2 cv = Cc[(d * 16 + pp) * 64 + n], a = apw[(d * 64 + n) * 17 + (d == 0 ? t + 1 : 16 - t)];
            const float zr = cv.x * a.x - cv.y * a.y, zi = cv.x * a.y + cv.y * a.x; v = c == 0 ? zr : -zi; }
        Wb[idx2] = f2bf(v); } } }
    __syncthreads();
}

__device__ __forceinline__ void phase_prep(const Ctx& p, LAS unsigned char* lds, int stage) {
    const int bid = blockIdx.x, nb = gridDim.x, tid = otid();
    if (stage == 0) { for (int it = bid; it < 192; it += nb) mod_item(p, it, (LAS float*)lds); return; }
    for (int it = bid; it < 128 + 736; it += nb) {
        if (it < 128) s5_build(p, it >> 2, it & 3, lds);
        else convert_item(p, 0, it - 128, (LAS float*)lds);
    }
    const size_t gt = (size_t)bid * 512 + tid, gs = (size_t)nb * 512;
    { bf16_t* KS = (bf16_t*)(p.ws() + A_KS); const float* ck = p.in(2);
      for (size_t i = gt; i < 4 * 512 * 64; i += gs) { const int c8 = (int)(i & 63) * 8; const int kk = (int)(i >> 6) & 511; const int sb = (int)(i >> 15);
          const float* s = ck + ((size_t)(sb * 512 + kk)) * 512 + c8; const f32x4 a = *(const f32x4*)s, b = *(const f32x4*)(s + 4);
          u32x4 w; w.x = cvt_pk_bf16(a[0], a[1]); w.y = cvt_pk_bf16(a[2], a[3]); w.z = cvt_pk_bf16(b[0], b[1]); w.w = cvt_pk_bf16(b[2], b[3]);
          *(u32x4*)(KS + ((size_t)(sb * 2560 + 2048 + kk)) * 512 + c8) = w; } }
    { bf16_t* VTS = (bf16_t*)(p.ws() + A_VTS); const float* cvv = p.in(3);
      for (size_t i = gt; i < 4 * 64 * 512; i += gs) { const int col = (int)(i & 511); const int k8 = (int)(i >> 9) & 63; const int sb = (int)(i >> 15);
          const float* s = cvv + ((size_t)(sb * 512 + k8 * 8)) * 512 + col; float v[8];
#pragma unroll
          for (int q = 0; q < 8; ++q) v[q] = s[(size_t)q * 512];
          u32x4 w; w.x = cvt_pk_bf16(v[0], v[1]); w.y = cvt_pk_bf16(v[2], v[3]); w.z = cvt_pk_bf16(v[4], v[5]); w.w = cvt_pk_bf16(v[6], v[7]);
          *(u32x4*)(VTS + ((size_t)(sb * 512 + col)) * 2560 + 2048 + k8 * 8) = w; } }
    { f32x2* rope = (f32x2*)(p.ws() + M_ROPE);
      for (size_t i = gt; i < 2048 * 32; i += gs) { const int f = (int)(i & 15), a = (int)(i >> 4) & 1, t = (int)(i >> 5); const float pos = (float)(a == 0 ? (t >> 6) : (t & 63));
          const float inv = exp2f(-(float)f * (13.287712379549449f / 16.0f)); float s, c; sincosf(pos * inv, &s, &c); rope[i] = (f32x2){c, s}; } }
    { float* sp8 = (float*)(p.ws() + M_SP8); for (size_t i = gt; i < 1024; i += gs) { const float lam = p.in(32)[i]; sp8[i] = 8.0f * log1pf(expf(-lam)); } }
    if (bid == 0 && tid < 64) { const float* dl = p.in(21); const float s01 = wave_sum(dl[tid] * dl[64 + tid]), s23 = wave_sum(dl[128 + tid] * dl[192 + tid]);
        if (tid == 0) ((float*)(p.ws() + M_SCAL))[0] = expf(s01) - expf(s23) + 0.2f; }
}

__device__ __forceinline__ void phase_convert_l1(const Ctx& p, LAS unsigned char* lds, int it_lo = 0, int it_hi = 752, bool gate = true) {
    const int bid = blockIdx.x, nb = gridDim.x, tid = otid();
    for (int it = it_lo + bid; it < it_hi; it += nb) convert_item(p, 1, it, (LAS float*)lds);
    if (!gate) return;
    bf16_t* Wg = (bf16_t*)(p.ws() + W_GATE);
    for (size_t i = (size_t)bid * 512 + tid; i < 2048 * 64; i += (size_t)nb * 512) { const int k0 = (int)(i & 63) * 8; const int cp = (int)(i >> 6);
        const int dir = cp >> 10, rest = cp & 1023, blk32 = rest >> 5, gate = (rest >> 4) & 1, ch = blk32 * 16 + (rest & 15), blk = ch >> 6, dout = ch & 63;
        u32x4 w = (u32x4){0u, 0u, 0u, 0u};
        if ((k0 >> 6) == blk) { const float* src = (gate ? p.in(30) : p.in(28)) + (((size_t)(dir * 8 + blk) * 64 + (k0 & 63)) * 64 + dout);
            w.x = cvt_pk_bf16(src[0], src[64]); w.y = cvt_pk_bf16(src[128], src[192]); w.z = cvt_pk_bf16(src[256], src[320]); w.w = cvt_pk_bf16(src[384], src[448]); }
        *(u32x4*)(Wg + (size_t)cp * 512 + k0) = w; }
}

template <bool POST, bool PRE, bool XIN>
__device__ __forceinline__ void post_pre(const Ctx& p, int lpost, int jpost, int lpre, int jpre) {
    const int lane = otid() & 63, gw = blockIdx.x * 8 + (otid() >> 6), nw = gridDim.x * 8;
    const float* MOD = (const float*)(p.ws() + M_MOD); const float* ng = p.in(10);
    float* X = p.out(); const bf16_t* Y = (const bf16_t*)(p.ws() + A_Y); bf16_t* H = (bf16_t*)(p.ws() + WS_H);
    for (int row = gw; row < NTOK; row += nw) {
        const int cv = row < NPROMPT ? 0 : 1 + ((row - NPROMPT) >> 11);
        const float* xr = XIN ? (row < NPROMPT ? p.in(0) + (size_t)row * DM : p.in(1) + (size_t)(row - NPROMPT) * DM) : X + (size_t)row * DM;
        f32x4 x[4];
#pragma unroll
        for (int i = 0; i < 4; ++i) x[i] = *(const f32x4*)(xr + 4 * lane + 256 * i);
        if (POST) {
            f32x4 y[4]; float ss = 0.f;
#pragma unroll
            for (int i = 0; i < 4; ++i) { const u32x2 yw = *(const u32x2*)(Y + (size_t)row * DM + 4 * lane + 256 * i); y[i] = (f32x4){bflo(yw.x), bfhi(yw.x), bflo(yw.y), bfhi(yw.y)};
                ss += y[i][0] * y[i][0] + y[i][1] * y[i][1] + y[i][2] * y[i][2] + y[i][3] * y[i][3]; }
            ss = wave_sum(ss); const float r = rsqrtf(ss * (1.0f / 1024.0f) + 1e-6f);
            const float* gp = ng + (lpost * 4 + (jpost ? 3 : 1)) * 1024; const float* gate = MOD + ((size_t)(lpost * 5 + cv) * 6 + 3 * jpost + 2) * 1024;
#pragma unroll
            for (int i = 0; i < 4; ++i) { const f32x4 g4 = *(const f32x4*)(gp + 4 * lane + 256 * i), t4 = *(const f32x4*)(gate + 4 * lane + 256 * i);
                x[i] = x[i] + t4 * (y[i] * r * g4); *(f32x4*)(X + (size_t)row * DM + 4 * lane + 256 * i) = x[i]; }
        }
        if (PRE) {
            float ss = 0.f;
#pragma unroll
            for (int i = 0; i < 4; ++i) ss += x[i][0] * x[i][0] + x[i][1] * x[i][1] + x[i][2] * x[i][2] + x[i][3] * x[i][3];
            ss = wave_sum(ss); const float r = rsqrtf(ss * (1.0f / 1024.0f) + 1e-6f);
            const float* gq = ng + (lpre * 4 + (jpre ? 2 : 0)) * 1024; const float* sh = MOD + ((size_t)(lpre * 5 + cv) * 6 + 3 * jpre) * 1024; const float* sc = sh + 1024;
#pragma unroll
            for (int i = 0; i < 4; ++i) { const f32x4 g4 = *(const f32x4*)(gq + 4 * lane + 256 * i), s4 = *(const f32x4*)(sh + 4 * lane + 256 * i), c4 = *(const f32x4*)(sc + 4 * lane + 256 * i);
                const f32x4 h = x[i] * r * g4 * (1.0f + c4) + s4; u32x2 w; w.x = cvt_pk_bf16(h[0], h[1]); w.y = cvt_pk_bf16(h[2], h[3]);
                *(u32x2*)(H + (size_t)row * DM + 4 * lane + 256 * i) = w;
                if (XIN && !POST) { u32x2 xb; xb.x = cvt_pk_bf16(x[i][0], x[i][1]); xb.y = cvt_pk_bf16(x[i][2], x[i][3]);
                    *(u32x2*)((bf16_t*)X + (size_t)row * DM + 4 * lane + 256 * i) = xb; } }
        }
    }
}

__device__ __forceinline__ void attn_item(const Ctx& p, LAS unsigned char* lds, bool samp, int b, int h, int qb) {
    int tid_ = otid();
    const int tid = tid_, wid = tid >> 6, lane = tid & 63, fr = lane & 15, fq = lane >> 4;
    const int Lk = samp ? 2560 : 256;
    const int row0 = samp ? NPROMPT + b * 2048 + qb * 128 : b * 256 + qb * 128;
    const bf16_t* Kb = samp ? (const bf16_t*)(p.ws() + A_KS) + (size_t)b * 2560 * 512 : (const bf16_t*)(p.ws() + A_KP) + (size_t)b * 256 * 512;
    const bf16_t* Vt = (samp ? (const bf16_t*)(p.ws() + A_VTS) : (const bf16_t*)(p.ws() + A_VTP)) + (size_t)(b * 4 + h) * 128 * Lk;
    const bf16_t* Qp = (const bf16_t*)(p.ws() + A_Q) + (size_t)(row0 + wid * 16 + fr) * 512 + h * 128;
    bf16x8 Qf[2][2];
#pragma unroll
    for (int m = 0; m < 2; ++m)
#pragma unroll
        for (int ks = 0; ks < 2; ++ks) Qf[m][ks] = *(const bf16x8*)(Qp + m * 64 + ks * 32 + fq * 8);
    f32x4 O[2][8];
#pragma unroll
    for (int m = 0; m < 2; ++m)
#pragma unroll
        for (int k = 0; k < 8; ++k) O[m][k] = (f32x4){0.f, 0.f, 0.f, 0.f};
    float mrun[2] = {-INFINITY, -INFINITY}, lrun[2] = {0.f, 0.f};
    const float csc = 0.125f * 1.4426950408889634f;
    const int kkey = tid >> 3, kpart = tid & 7, vdv = tid >> 2, vpart = tid & 3;
    const bf16_t* ksrc = Kb + (size_t)kkey * 512 + h * 128 + kpart * 16;
    const bf16_t* vsrc = Vt + (size_t)vdv * Lk + vpart * 16;
    const int kdst = ((kpart >> 2) * 64 + kkey) * 144 + (kpart & 3) * 32, vdst = 2 * 64 * 144 + vdv * 144 + vpart * 32;
    const int ntile = Lk / 64;
    u32x4 kr0 = *(const u32x4*)ksrc, kr1 = *(const u32x4*)(ksrc + 8), vr0 = *(const u32x4*)vsrc, vr1 = *(const u32x4*)(vsrc + 8);
    __syncthreads();
#define ATT_STORE(LB) do { *(LAS u32x4*)((LB) + kdst) = kr0; *(LAS u32x4*)((LB) + kdst + 16) = kr1; *(LAS u32x4*)((LB) + vdst) = vr0; *(LAS u32x4*)((LB) + vdst + 16) = vr1; } while (0)
#define ATT_FETCH(T) do { const bf16_t* ks2 = ksrc + (size_t)(T) * 64 * 512; const bf16_t* vs2 = vsrc + (T) * 64; \
        kr0 = *(const u32x4*)ks2; kr1 = *(const u32x4*)(ks2 + 8); vr0 = *(const u32x4*)vs2; vr1 = *(const u32x4*)(vs2 + 8); } while (0)
#define ATT_QK(S, LB) do { _Pragma("unroll") for (int m = 0; m < 2; ++m) { _Pragma("unroll") for (int kb = 0; kb < 4; ++kb) { S[m][kb] = (f32x4){0.f, 0.f, 0.f, 0.f}; \
        _Pragma("unroll") for (int ks = 0; ks < 2; ++ks) { const bf16x8 A_ = *(const LAS bf16x8*)((LB) + (m * 64 + kb * 16 + fr) * 144 + (ks * 32 + fq * 8) * 2); \
            S[m][kb] = __builtin_amdgcn_mfma_f32_16x16x32_bf16(A_, Qf[m][ks], S[m][kb], 0, 0, 0); } } __builtin_amdgcn_sched_barrier(0); } } while (0)
    f32x4 s[2][4];
    ATT_STORE(lds);
    __syncthreads();
    if (ntile > 1) ATT_FETCH(1);
    ATT_QK(s, lds);
    int bcur = 0, bnxt = 1;
    for (int kt = 0; kt < ntile; ++kt) {
        LAS unsigned char* ldsV = lds + bcur * 36864 + 2 * 64 * 144;
        const bool more = kt + 1 < ntile;
        f32x4 sn[2][4];
        if (more) { LAS unsigned char* lb1 = lds + bnxt * 36864;
            ATT_STORE(lb1);
            __syncthreads();
            if (kt + 2 < ntile) ATT_FETCH(kt + 2);
            ATT_QK(sn, lb1); }
        float tmax[2];
#pragma unroll
        for (int m = 0; m < 2; ++m) { float t = s[m][0][0];
#pragma unroll
            for (int kb = 0; kb < 4; ++kb)
#pragma unroll
                for (int j = 0; j < 4; ++j) t = fmaxf(t, s[m][kb][j]);
            tmax[m] = t; }
        tmax[0] = fmaxf(tmax[0], __shfl_xor(tmax[0], 16)); tmax[1] = fmaxf(tmax[1], __shfl_xor(tmax[1], 16));
        tmax[0] = fmaxf(tmax[0], __shfl_xor(tmax[0], 32)); tmax[1] = fmaxf(tmax[1], __shfl_xor(tmax[1], 32));
#pragma unroll
        for (int m = 0; m < 2; ++m) {
            const float mnew = fmaxf(mrun[m], tmax[m]); const float alpha = __builtin_amdgcn_exp2f((mrun[m] - mnew) * csc); mrun[m] = mnew;
            const float mc = mnew * csc;
            float psum = 0.f;
#pragma unroll
            for (int kb = 0; kb < 4; ++kb)
#pragma unroll
                for (int j = 0; j < 4; ++j) { s[m][kb][j] = __builtin_amdgcn_exp2f(s[m][kb][j] * csc - mc); psum += s[m][kb][j]; }
            lrun[m] = lrun[m] * alpha + psum;
#pragma unroll
            for (int k = 0; k < 8; ++k) O[m][k] *= alpha;
        }
#pragma unroll
        for (int kg = 0; kg < 2; ++kg) {
            bf16x8 B[2];
#pragma unroll
            for (int m = 0; m < 2; ++m) { u32x4 pw; pw.x = cvt_pk_bf16(s[m][2 * kg][0], s[m][2 * kg][1]); pw.y = cvt_pk_bf16(s[m][2 * kg][2], s[m][2 * kg][3]);
                pw.z = cvt_pk_bf16(s[m][2 * kg + 1][0], s[m][2 * kg + 1][1]); pw.w = cvt_pk_bf16(s[m][2 * kg + 1][2], s[m][2 * kg + 1][3]); B[m] = __builtin_bit_cast(bf16x8, pw); }
#pragma unroll
            for (int blk = 0; blk < 8; ++blk) { LAS unsigned char* vp = ldsV + (blk * 16 + fr) * 144 + (kg * 32 + 4 * fq) * 2;
                const u32x2 lo = *(const LAS u32x2*)vp, hi = *(const LAS u32x2*)(vp + 32);
                const bf16x8 A = __builtin_bit_cast(bf16x8, ((u32x4){lo.x, lo.y, hi.x, hi.y}));
                O[0][blk] = __builtin_amdgcn_mfma_f32_16x16x32_bf16(A, B[0], O[0][blk], 0, 0, 0);
                O[1][blk] = __builtin_amdgcn_mfma_f32_16x16x32_bf16(A, B[1], O[1][blk], 0, 0, 0); }
            __builtin_amdgcn_sched_barrier(0);
        }
        if (more) {
#pragma unroll
            for (int m = 0; m < 2; ++m)
#pragma unroll
                for (int kb = 0; kb < 4; ++kb) s[m][kb] = sn[m][kb]; }
        bcur = bnxt; bnxt = bnxt == 2 ? 0 : bnxt + 1;
    }
#undef ATT_STORE
#undef ATT_FETCH
#undef ATT_QK
    float l0 = lrun[0], l1 = lrun[1];
    l0 += __shfl_xor(l0, 16); l0 += __shfl_xor(l0, 32); l1 += __shfl_xor(l1, 16); l1 += __shfl_xor(l1, 32);
    const float lam = ((const float*)(p.ws() + M_SCAL))[0];
    const float i0 = 1.0f / l0, i1 = lam / l1;
    float ss = 0.f;
#pragma unroll
    for (int k = 0; k < 8; ++k)
#pragma unroll
        for (int j = 0; j < 4; ++j) { const float o = O[0][k][j] * i0 - O[1][k][j] * i1; O[0][k][j] = o; ss += o * o; }
    ss += __shfl_xor(ss, 16); ss += __shfl_xor(ss, 32);
    const float r = rsqrtf(ss * (1.0f / 128.0f) + 1e-6f) * 0.8f;
    bf16_t* outp = (bf16_t*)(p.ws() + WS_H) + (size_t)(row0 + wid * 16 + fr) * 1024 + 512 + h * 128;
    const float* dg = p.in(22);
#pragma unroll
    for (int k = 0; k < 8; ++k) { const f32x4 g4 = *(const f32x4*)(dg + k * 16 + 4 * fq); const f32x4 o = O[0][k] * r * g4;
        u32x2 w; w.x = cvt_pk_bf16(o[0], o[1]); w.y = cvt_pk_bf16(o[2], o[3]); *(u32x2*)(outp + k * 16 + 4 * fq) = w; }
}
__device__ __forceinline__ void phase_attn(const Ctx& p, LAS unsigned char* lds) {
    for (int it = blockIdx.x; it < 256; it += gridDim.x) {
        attn_item(p, lds, true, it >> 6, (it >> 4) & 3, it & 15);
        attn_item(p, lds, false, it >> 3, (it >> 1) & 3, it & 1);
    }
}

__device__ __forceinline__ void s5_rec_one(const Ctx& p, const float* E, bf16_t* AB, int n, int d, int g, int sq) {
    const float *lam_re = p.in(13), *lam_im = p.in(14), *log_dt = p.in(15);
    const bool samp = sq < 4; const int j0 = samp ? 512 + 128 * sq : 16 * (sq - 4), nj = samp ? 128 : 16;
    const float dt = expf(log_dt[d * 32 + g]); const float lr = lam_re[(d * 32 + g) * 64 + n], li = lam_im[(d * 32 + g) * 64 + n];
    const float mag = expf(16.0f * lr * dt); float sn, cs; sincosf(16.0f * li * dt, &sn, &cs); const float ar = mag * cs, ai = mag * sn;
    float sr = 0.f, si = 0.f;
    if (samp) { sr = p.in(4)[((size_t)((sq * 2 + d) * 2 + 0) * 32 + g) * 64 + n]; si = p.in(4)[((size_t)((sq * 2 + d) * 2 + 1) * 32 + g) * 64 + n]; }
    const int eo = d * 128 + n, so = 256 + d * 128 + n;
    for (int jj = 0; jj < nj; jj += 16) {
        float er[16], ei[16];
#pragma unroll
        for (int u = 0; u < 16; ++u) { const int j = d == 0 ? j0 + jj + u : j0 + nj - 1 - jj - u; const float* ep = E + ((size_t)(g * 1024 + j)) * 256 + eo; er[u] = ep[0]; ei[u] = ep[64]; }
#pragma unroll
        for (int u = 0; u < 16; ++u) { const int j = d == 0 ? j0 + jj + u : j0 + nj - 1 - jj - u; bf16_t* sp = AB + ((size_t)(g * 1024 + j)) * 512 + so;
            sp[0] = f2bf(sr); sp[64] = f2bf(si);
            const float nr = ar * sr - ai * si + er[u], ni = ar * si + ai * sr + ei[u]; sr = nr; si = ni; }
    }
    if (!samp) { float* o = p.out() + O_S5 + ((size_t)(((sq - 4) * 2 + d) * 2) * 32 + g) * 64 + n; o[0] = sr; o[2048] = si; }
}
__device__ __forceinline__ void phase_s5_rec(const Ctx& p, int bid, int nblk) {
    const float* E = (const float*)(p.ws() + A_E); bf16_t* AB = (bf16_t*)(p.ws() + A_AB);
    for (int idx = bid * 512 + otid(); idx < 36 * 4096; idx += nblk * 512) s5_rec_one(p, E, AB, idx & 63, (idx >> 6) & 1, (idx >> 7) & 31, idx >> 12);
}
__device__ __forceinline__ void s5_rec_unit(const Ctx& p, int L) {
    const float* E = (const float*)(p.ws() + A_E); bf16_t* AB = (bf16_t*)(p.ws() + A_AB);
    const int g = L >> 2, i = L & 3, nitems = i < 2 ? 2048 : 256;
    for (int idx = otid(); idx < nitems; idx += 512) { const int sl = idx >> 7; s5_rec_one(p, E, AB, idx & 63, (idx >> 6) & 1, g, i < 2 ? 4 + 16 * i + sl : 2 * (i - 2) + sl); }
}

__device__ __forceinline__ void phase_ffn_conv(const Ctx& p, int layer, int hf) {
    const bf16_t* U = (const bf16_t*)(p.ws() + A_U); bf16_t* A2 = (bf16_t*)(p.ws() + A_A2) + (size_t)hf * 8192 * 2816;
    const float* cw = p.in(34) + (size_t)layer * 3 * 5632; const float* cb = p.in(35) + (size_t)layer * 5632;
    const int Lm = hf ? 2047 : 255;
    for (size_t idx = (size_t)blockIdx.x * 512 + otid(); idx < (size_t)8192 * 352; idx += (size_t)gridDim.x * 512) {
        const int cc = (int)(idx % 352) * 8; const int rl = (int)(idx / 352); const int pos = rl & Lm;
        float g[8], v[8];
#pragma unroll
        for (int e = 0; e < 8; ++e) { g[e] = cb[cc + e]; v[e] = cb[2816 + cc + e]; }
#pragma unroll
        for (int j = 0; j < 3; ++j) { const int dj = j - 1; if ((dj < 0 && pos == 0) || (dj > 0 && pos == Lm)) continue;
            const bf16_t* ur = U + (size_t)(rl + dj) * 5632 + cc; float a[8], b[8]; unpack8(*(const u32x4*)ur, a); unpack8(*(const u32x4*)(ur + 2816), b);
            const float* w = cw + j * 5632 + cc;
#pragma unroll
            for (int e = 0; e < 8; ++e) { g[e] += w[e] * a[e]; v[e] += w[2816 + e] * b[e]; } }
        float o[8];
#pragma unroll
        for (int e = 0; e < 8; ++e) o[e] = gelu_t(g[e]) * v[e];
        u32x4 w; w.x = cvt_pk_bf16(o[0], o[1]); w.y = cvt_pk_bf16(o[2], o[3]); w.z = cvt_pk_bf16(o[4], o[5]); w.w = cvt_pk_bf16(o[6], o[7]);
        *(u32x4*)(A2 + (size_t)rl * 2816 + cc) = w;
    }
}

__device__ __forceinline__ void phase_cd_conv(const Ctx& p) {
    const bf16_t *XIN = (const bf16_t*)(p.ws() + A_XIN), *BG = (const bf16_t*)(p.ws() + A_BG), *CG = (const bf16_t*)(p.ws() + A_CG), *XR = (const bf16_t*)(p.ws() + A_XR);
    bf16_t* CAT = (bf16_t*)(p.ws() + WS_H); bf16_t* XC = (bf16_t*)(p.ws() + A_XC);
    const float *scw = p.in(25), *cw = p.in(26), *cb = p.in(27);
    for (size_t idx = (size_t)blockIdx.x * 512 + otid(); idx < (size_t)NTOK * 64; idx += (size_t)gridDim.x * 512) {
        const int ch = (int)(idx & 63) * 8; const int row = (int)(idx >> 6);
        const int pos = row < NPROMPT ? (row & 255) : ((row - NPROMPT) & 2047); const int L = row < NPROMPT ? 256 : 2048;
        float yc[8], xc[8];
#pragma unroll
        for (int e = 0; e < 8; ++e) { yc[e] = 0.f; xc[e] = cb[ch + e]; }
#pragma unroll
        for (int j = 0; j < 3; ++j) { const int t = pos + j - 1; if (t < 0 || t >= L) continue;
            float a[8], b[8]; unpack8(*(const u32x4*)(CG + (size_t)(row + j - 1) * 512 + ch), a); unpack8(*(const u32x4*)(XIN + (size_t)(row + j - 1) * 512 + ch), b);
#pragma unroll
            for (int e = 0; e < 8; ++e) yc[e] += scw[j * 512 + ch + e] * (a[e] * b[e]); }
#pragma unroll
        for (int j = 0; j < 4; ++j) { const int t = pos + j - 2; if (t < 0 || t >= L) continue;
            float a[8]; unpack8(*(const u32x4*)(XR + (size_t)(row + j - 2) * 512 + ch), a);
#pragma unroll
            for (int e = 0; e < 8; ++e) xc[e] += cw[j * 512 + ch + e] * a[e]; }
        float bg[8]; unpack8(*(const u32x4*)(BG + (size_t)row * 512 + ch), bg);
#pragma unroll
        for (int e = 0; e < 8; ++e) yc[e] *= bg[e];
        u32x4 w; w.x = cvt_pk_bf16(yc[0], yc[1]); w.y = cvt_pk_bf16(yc[2], yc[3]); w.z = cvt_pk_bf16(yc[4], yc[5]); w.w = cvt_pk_bf16(yc[6], yc[7]);
        *(u32x4*)(CAT + (size_t)row * 1024 + ch) = w;
        w.x = cvt_pk_bf16(xc[0], xc[1]); w.y = cvt_pk_bf16(xc[2], xc[3]); w.z = cvt_pk_bf16(xc[4], xc[5]); w.w = cvt_pk_bf16(xc[6], xc[7]);
        *(u32x4*)(XC + (size_t)row * 512 + ch) = w;
    }
}

constexpr size_t M_SEG = WS_MISC + 1024 * 1024;
template <int D>
__device__ __forceinline__ void lru_load(const bf16_t* LA, const bf16_t* BV, int sg, int w, int ch, unsigned short (&la)[32], unsigned short (&bv)[32]) {
    const long row0 = D == 0 ? 256 * sg + 32 * w : 256 * sg + 255 - 32 * w;
    const bf16_t* pl = LA + ((size_t)D * NTOK + row0) * 512 + ch; const bf16_t* pb = BV + ((size_t)D * NTOK + row0) * 512 + ch;
#pragma unroll
    for (int i = 0; i < 32; ++i) { la[i] = pl[(D == 0 ? i : -i) * 512]; bv[i] = pb[(D == 0 ? i : -i) * 512]; }
}
__device__ __forceinline__ void lru_agg(const unsigned short (&la)[32], const unsigned short (&bv)[32], float& Pw, float& Ew) {
    Pw = 1.f; Ew = 0.f;
#pragma unroll
    for (int i = 0; i < 32; ++i) { const float a = __expf(bf2f(la[i])); Ew = a * Ew + bf2f(bv[i]); Pw *= a; }
}
__device__ __forceinline__ void phase_lru_a(const Ctx& p, LAS unsigned char* lds) {
    const int tid = otid(), w = tid >> 6, lane = tid & 63;
    LAS float* PE = (LAS float*)lds;
    const bf16_t *LA = (const bf16_t*)(p.ws() + A_LA), *BV = (const bf16_t*)(p.ws() + A_BV);
    float* SEG = (float*)(p.ws() + M_SEG);
    for (int it = blockIdx.x; it < 512; it += gridDim.x) {
        const int sg = it >> 3, ch = (it & 7) * 64 + lane;
        { unsigned short la[32], bv[32]; lru_load<0>(LA, BV, sg, w, ch, la, bv); float Pw, Ew; lru_agg(la, bv, Pw, Ew); PE[w * 64 + lane] = Pw; PE[1024 + w * 64 + lane] = Ew; }
        { unsigned short la[32], bv[32]; lru_load<1>(LA, BV, sg, w, ch, la, bv); float Pw, Ew; lru_agg(la, bv, Pw, Ew); PE[(8 + w) * 64 + lane] = Pw; PE[1024 + (8 + w) * 64 + lane] = Ew; }
        __syncthreads();
        if (w < 2) { float P = 1.f, E = 0.f;
#pragma unroll
            for (int w2 = 0; w2 < 8; ++w2) { const float P2 = PE[(w * 8 + w2) * 64 + lane], E2 = PE[1024 + (w * 8 + w2) * 64 + lane]; E = P2 * E + E2; P *= P2; }
            *(f32x2*)(SEG + ((size_t)(w * 64 + sg) * 512 + ch) * 2) = (f32x2){P, E}; }
        __syncthreads();
    }
}
__device__ __forceinline__ void phase_lru_b(const Ctx& p, LAS unsigned char* lds) {
    const int tid = otid(), w = tid >> 6, lane = tid & 63;
    LAS float* HFs = (LAS float*)lds;
    LAS float* PE = (LAS float*)(lds + 65536);
    const bf16_t *LA = (const bf16_t*)(p.ws() + A_LA), *BV = (const bf16_t*)(p.ws() + A_BV), *GB = (const bf16_t*)(p.ws() + A_GB);
    const float* SEG = (const float*)(p.ws() + M_SEG); bf16_t* CAT = (bf16_t*)(p.ws() + WS_H);
    for (int it = blockIdx.x; it < 512; it += gridDim.x) {
        const int sg = it >> 3, ch = (it & 7) * 64 + lane;
        const bool samp = sg >= 32; const int sb = (sg - 32) >> 3, sp = (sg - 32) & 7;
        { unsigned short la[32], bv[32]; lru_load<0>(LA, BV, sg, w, ch, la, bv);
          float c = samp ? p.in(5)[(size_t)(sb * 2 + 0) * 512 + ch] : 0.f;
          if (samp) {
#pragma unroll
              for (int s2 = 0; s2 < 7; ++s2) if (s2 < sp) { const f32x2 pe = *(const f32x2*)(SEG + ((size_t)(0 * 64 + 32 + 8 * sb + s2) * 512 + ch) * 2); c = pe.x * c + pe.y; } }
          float Pw, Ew; lru_agg(la, bv, Pw, Ew); PE[w * 64 + lane] = Pw; PE[512 + w * 64 + lane] = Ew;
          __syncthreads();
          float cseg = c;
#pragma unroll
          for (int w2 = 0; w2 < 8; ++w2) { const float P2 = PE[w2 * 64 + lane], E2 = PE[512 + w2 * 64 + lane]; cseg = P2 * cseg + E2; if (w2 < w) c = P2 * c + E2; }
          float h = c;
#pragma unroll
          for (int i = 0; i < 32; ++i) { h = __expf(bf2f(la[i])) * h + bf2f(bv[i]); HFs[(32 * w + i) * 64 + lane] = h; }
          if (!samp && w == 0) p.out()[O_LRU + (size_t)(sg * 2 + 0) * 512 + ch] = cseg;
          __syncthreads(); }
        { unsigned short la[32], bv[32], gb[32]; lru_load<1>(LA, BV, sg, w, ch, la, bv);
          const long row0 = 256 * sg + 255 - 32 * w;
          { const bf16_t* pg = GB + (size_t)row0 * 512 + ch;
#pragma unroll
            for (int i = 0; i < 32; ++i) gb[i] = pg[-i * 512]; }
          float c = samp ? p.in(5)[(size_t)(sb * 2 + 1) * 512 + ch] : 0.f;
          if (samp) {
#pragma unroll
              for (int s2 = 7; s2 > 0; --s2) if (s2 > sp) { const f32x2 pe = *(const f32x2*)(SEG + ((size_t)(1 * 64 + 32 + 8 * sb + s2) * 512 + ch) * 2); c = pe.x * c + pe.y; } }
          float Pw, Ew; lru_agg(la, bv, Pw, Ew); PE[w * 64 + lane] = Pw; PE[512 + w * 64 + lane] = Ew;
          __syncthreads();
          float cseg = c;
#pragma unroll
          for (int w2 = 0; w2 < 8; ++w2) { const float P2 = PE[w2 * 64 + lane], E2 = PE[512 + w2 * 64 + lane]; cseg = P2 * cseg + E2; if (w2 < w) c = P2 * c + E2; }
          float h = c; bf16_t* pc = CAT + (size_t)row0 * 1024 + 512 + ch;
#pragma unroll
          for (int i = 0; i < 32; ++i) { h = __expf(bf2f(la[i])) * h + bf2f(bv[i]); const float hs = HFs[(255 - 32 * w - i) * 64 + lane] + h;
              pc[-i * 1024] = f2bf(hs * gelu_t(bf2f(gb[i]))); }
          if (!samp && w == 0) p.out()[O_LRU + (size_t)(sg * 2 + 1) * 512 + ch] = cseg;
          __syncthreads(); }
    }
}

#define REPG 1
#define REPO 1
#define REPS 1
#define REP_ATTN 1
#define REP_PREP 1
#define REP_FCONV 1
#define MAKE_EPOST(FROMIN, LPOST, JPOST, HASPRE, LPRE, JPRE, INST) pg8::EpiPost{p.in(0), p.in(1), p.out(), (bf16_t*)(ws + WS_H), (const float*)(ws + M_MOD), p.in(10), \
        FROMIN, LPOST, JPOST, HASPRE, LPRE, JPRE, (float*)(ws + M_ST), p.barp() + 20 * 64, 4u * (INST), \
        (INST) == 4 ? (const bf16_t*)(ws + A_Y) : (const bf16_t*)p.out(), (INST) == 4 ? (bf16_t*)nullptr : ((INST) == 3 ? (bf16_t*)(ws + A_Y) : (bf16_t*)p.out())}
#define REPG_LOOP _Pragma("unroll 1") for (int rep_ = 0; rep_ < REPG; ++rep_)
#define REPO_LOOP _Pragma("unroll 1") for (int rep_ = 0; rep_ < REPO; ++rep_)
#define GSYNC() do { _Pragma("unroll 1") for (int rs_ = 0; rs_ < REPS; ++rs_) { ++bgen; xcd_barrier(p.xbarp(), (volatile LAS unsigned*)(lds + XB_ST_OFF), gridDim.x); } } while (0)
template <class GridT>
__device__ __forceinline__ void ffn_block(const Ctx& p, LAS unsigned char* lds, GridT& grid, int layer, unsigned& bgen) {
    const int G = gridDim.x, c = blockIdx.x;
#define ws (p.ws())
    { pg8::Gemm g{(const bf16_t*)(ws + WS_H), (const bf16_t*)(ws + W_UP), 1024, 1024, 1024};
      pg8::FfnOrder S; S.init2(G, c); pg8::EpiFfnUp E{(bf16_t*)(ws + A_A2), p.in(34) + (size_t)layer * 3 * 5632, p.in(35) + (size_t)layer * 5632};
      REPG_LOOP pg8::gemm_phase(lds, g, S, E); }
    GSYNC();
    if (G == 256) {
        pg8::Gemm g{(const bf16_t*)(ws + A_A2), (const bf16_t*)(ws + W_DOWN), 2816, 2816, 2816};
        pg8::StaticOrder S; S.init(NTOK, 1024, G, c);
        if (layer == 0) { pg8::EpiPost E = MAKE_EPOST(0, 0, 1, 1, 1, 0, 2); pg8::gemm_phase(lds, g, S, E); phase_convert_l1(p, lds, 0, 576, true); }
        else { pg8::EpiPost E = MAKE_EPOST(0, 1, 1, 0, 0, 0, 4); pg8::gemm_phase(lds, g, S, E); }
        if (layer == 0) GSYNC();
    } else {
    { pg8::Gemm g{(const bf16_t*)(ws + A_A2), (const bf16_t*)(ws + W_DOWN), 2816, 2816, 2816};
      pg8::StaticOrder S; S.init(NTOK, 1024, G, c); pg8::EpiBf16 E{(bf16_t*)(ws + A_Y), 1024, 64, 0};
      REPG_LOOP pg8::gemm_phase(lds, g, S, E); }
    GSYNC();
    if (layer == 0) { post_pre<true, true, false>(p, 0, 1, 1, 0); phase_convert_l1(p, lds); GSYNC(); }
    else post_pre<true, false, false>(p, 1, 1, 0, 0);
    }
#undef ws
}

__global__ void __launch_bounds__(512, 2) mega(Params kp) {
    extern __shared__ __attribute__((aligned(16))) unsigned char smem[];
    LAS unsigned char* lds = (LAS unsigned char*)smem;
    cg::grid_group grid = cg::this_grid();
    if (threadIdx.x == 64) { ((LAS unsigned*)(lds + XB_ST_OFF))[0] = 0u; ((LAS unsigned*)(lds + XB_ST_OFF))[1] = 0u; ((LAS unsigned*)(lds + XB_ST_OFF))[4] = 0u; ((LAS unsigned*)(lds + XB_ST_OFF))[5] = 0u; }
    if (threadIdx.x < 39) ((LAS unsigned long long*)(lds + TAB_OFF))[threadIdx.x] = ((const __attribute__((address_space(4))) unsigned long long*)__builtin_amdgcn_kernarg_segment_ptr())[threadIdx.x];
    __syncthreads();
    Ctx p; p.tab = (const LAS unsigned long long*)(lds + TAB_OFF);
    const int G = gridDim.x, c = blockIdx.x;
#define ws (p.ws())

    unsigned bgen = 0;
    if (blockIdx.x == 0 && threadIdx.x < 20 + 128) __hip_atomic_store(p.barp() + threadIdx.x * 64, 0u, __ATOMIC_RELAXED, __HIP_MEMORY_SCOPE_AGENT);
    if (blockIdx.x == 0) for (int i = threadIdx.x; i < 2 * XCD_BAR_WORDS; i += 512) __hip_atomic_store(p.xbarp() + i, 0u, __ATOMIC_RELAXED, __HIP_MEMORY_SCOPE_AGENT);
    phase_prep(p, lds, 0);
    grid.sync();
    if (threadIdx.x == 0 && blockIdx.x < 128) (void)xb_add(p.xbarp() + XCD_BAR_WORDS + XB_XCNT(xb_xcc_id()), 1u);
    if (threadIdx.x == 0) (void)xb_add(p.xbarp() + XB_XCNT(xb_xcc_id()), 1u);
    _Pragma("unroll 1") for (int rep_ = 0; rep_ < REP_PREP; ++rep_) phase_prep(p, lds, 1);
    REPO_LOOP post_pre<false, true, true>(p, 0, 0, 0, 0);
    GSYNC();
    { pg8::Gemm g{(const bf16_t*)(ws + WS_H), (const bf16_t*)(ws + W_INAB), 1024, 1024, 1024};
      pg8::StaticOrder S; S.init(NTOK, 2048, G, c);
      pg8::EpiInAB E{(bf16_t*)(ws + A_AB), (bf16_t*)(ws + A_Q), (bf16_t*)(ws + A_KP), (bf16_t*)(ws + A_KS), (bf16_t*)(ws + A_VTP), (bf16_t*)(ws + A_VTS), p.out() + O_K, p.out() + O_V, (const f32x2*)(ws + M_ROPE)};
      REPG_LOOP pg8::gemm_phase(lds, g, S, E); }
    GSYNC();
    if (G == 256) {
        if (c < 128) {
            unsigned* sflag = p.barp() + 19 * 64;
            { pg8::Gemm g{(const bf16_t*)(ws + A_AB), (const bf16_t*)(ws + A_HCAT), 512, 256, 256};
              pg8::S5Order S{128, c}; pg8::EpiF32<true> E{(float*)(ws + A_E), 256};
              pg8::gemm_phase(lds, g, S, E); }
            asm volatile("s_waitcnt vmcnt(0)" ::: "memory"); __syncthreads();
            s5_rec_unit(p, c);
            asm volatile("s_waitcnt vmcnt(0)" ::: "memory"); __syncthreads();
            { pg8::Gemm g{(const bf16_t*)(ws + A_AB), (const bf16_t*)(ws + A_WB), 512, 512, 512};
              pg8::S5Order S{128, c}; pg8::EpiS5B E{(bf16_t*)(ws + A_YS)};
              pg8::gemm_phase(lds, g, S, E); }
            asm volatile("s_waitcnt vmcnt(0)" ::: "memory"); __syncthreads();
            if (threadIdx.x == 0) { __builtin_amdgcn_fence(__ATOMIC_RELEASE, "agent"); asm volatile("s_waitcnt vmcnt(0)" ::: "memory");
                __hip_atomic_fetch_add(sflag, 1u, __ATOMIC_RELAXED, __HIP_MEMORY_SCOPE_AGENT); }
            attn_item(p, lds, true, c >> 6, (c >> 4) & 3, c & 15);
        } else {
            attn_item(p, lds, true, c >> 6, (c >> 4) & 3, c & 15);
            _Pragma("unroll 1") for (int u2 = 0; u2 < 2; ++u2) { const int it = 2 * (c - 128) + u2; attn_item(p, lds, false, it >> 3, (it >> 1) & 3, it & 1); }
            __syncthreads();
            if (threadIdx.x == 0) { unsigned* rel = p.barp() + 10 * 64 + 9 * 64; unsigned spins = 0;
                while (__hip_atomic_load(rel, __ATOMIC_RELAXED, __HIP_MEMORY_SCOPE_AGENT) < 128u && ++spins < (1u << 24)) __builtin_amdgcn_s_sleep(1);
                __builtin_amdgcn_fence(__ATOMIC_ACQUIRE, "agent");
                asm volatile("s_waitcnt vmcnt(0)" ::: "memory"); }
            __syncthreads();
            { pg8::Gemm g{(const bf16_t*)(ws + A_YS), (const bf16_t*)(ws + W_GLU), 512, 512, 512};
              pg8::StaticOrder S; S.init(NTOK, 512, 128, c - 128); pg8::EpiGLU E{(const bf16_t*)(ws + A_YS), (bf16_t*)(ws + WS_H), p.in(20)};
              pg8::gemm_phase(lds, g, S, E); }
        }
        GSYNC();
    } else {
    { pg8::Gemm g{(const bf16_t*)(ws + A_AB), (const bf16_t*)(ws + A_HCAT), 512, 256, 256};
      pg8::S5Order S{G, c}; pg8::EpiF32<true> E{(float*)(ws + A_E), 256};
      pg8::gemm_phase(lds, g, S, E); }
    phase_attn(p, lds);
    GSYNC();
    phase_s5_rec(p, c, G);
    GSYNC();
    { pg8::Gemm g{(const bf16_t*)(ws + A_AB), (const bf16_t*)(ws + A_WB), 512, 512, 512};
      pg8::S5Order S{G, c}; pg8::EpiS5B E{(bf16_t*)(ws + A_YS)};
      pg8::gemm_phase(lds, g, S, E); }
    GSYNC();
    { pg8::Gemm g{(const bf16_t*)(ws + A_YS), (const bf16_t*)(ws + W_GLU), 512, 512, 512};
      pg8::StaticOrder S; S.init(NTOK, 512, G, c); pg8::EpiGLU E{(const bf16_t*)(ws + A_YS), (bf16_t*)(ws + WS_H), p.in(20)};
      pg8::gemm_phase(lds, g, S, E); }
    GSYNC();
    }
    if (G == 256) {
        pg8::Gemm g{(const bf16_t*)(ws + WS_H), (const bf16_t*)(ws + W_OUT), 1024, 1024, 1024};
        pg8::StaticOrder S; S.init(NTOK, 1024, G, c); pg8::EpiPost E = MAKE_EPOST(0, 0, 0, 1, 0, 1, 1);
        pg8::gemm_phase(lds, g, S, E);
        GSYNC();
    } else {
    { pg8::Gemm g{(const bf16_t*)(ws + WS_H), (const bf16_t*)(ws + W_OUT), 1024, 1024, 1024};
      pg8::StaticOrder S; S.init(NTOK, 1024, G, c); pg8::EpiBf16 E{(bf16_t*)(ws + A_Y), 1024, 64, 0};
      REPG_LOOP pg8::gemm_phase(lds, g, S, E); }
    GSYNC();
    post_pre<true, true, true>(p, 0, 0, 0, 1);
    GSYNC();
    }
    ffn_block(p, lds, grid, 0, bgen);
    { pg8::Gemm g{(const bf16_t*)(ws + WS_H), (const bf16_t*)(ws + W_INCD), 1024, 1024, 1024};
      pg8::StaticOrder S; S.init(NTOK, 2560, G, c); pg8::EpiBf16 E{(bf16_t*)(ws + A_XIN), 512, 2, (size_t)NTOK * 512};
      REPG_LOOP pg8::gemm_phase(lds, g, S, E); }
    GSYNC();
    REPO_LOOP phase_cd_conv(p);
    if (G == 256) phase_convert_l1(p, lds, 576, 752, false);
    GSYNC();
    { pg8::Gemm g{(const bf16_t*)(ws + A_XC), (const bf16_t*)(ws + W_GATE), 512, 512, 256};
      pg8::GateOrder S; S.init(NTOK, 2048, G, c);
      pg8::EpiGate E{(const bf16_t*)(ws + A_XC), (bf16_t*)(ws + A_LA), (bf16_t*)(ws + A_BV), p.in(29), p.in(31), (const float*)(ws + M_SP8)};
      REPG_LOOP pg8::gemm_phase(lds, g, S, E); }
    GSYNC();
    phase_lru_a(p, lds);
    GSYNC();
    phase_lru_b(p, lds);
    GSYNC();
    if (G == 256) {
        pg8::Gemm g{(const bf16_t*)(ws + WS_H), (const bf16_t*)(ws + W_OUT), 1024, 1024, 1024};
        pg8::StaticOrder S; S.init(NTOK, 1024, G, c); pg8::EpiPost E = MAKE_EPOST(0, 1, 0, 1, 1, 1, 3);
        pg8::gemm_phase(lds, g, S, E);
        GSYNC();
    } else {
    { pg8::Gemm g{(const bf16_t*)(ws + WS_H), (const bf16_t*)(ws + W_OUT), 1024, 1024, 1024};
      pg8::StaticOrder S; S.init(NTOK, 1024, G, c); pg8::EpiBf16 E{(bf16_t*)(ws + A_Y), 1024, 64, 0};
      REPG_LOOP pg8::gemm_phase(lds, g, S, E); }
    GSYNC();
    post_pre<true, true, false>(p, 1, 0, 1, 1);
    GSYNC();
    }
    ffn_block(p, lds, grid, 1, bgen);
#undef ws
}

extern "C" void kernel_launch(void* const* d_in, const int* in_sizes, int n_in, void* d_out, int out_size, void* d_ws, size_t ws_size, hipStream_t stream) {
    static int grid_blocks = 0;
    if (!grid_blocks) {
        int dev = 0, cus = 0, per_cu = 0;
        hipGetDevice(&dev);
        hipDeviceGetAttribute(&cus, hipDeviceAttributeMultiprocessorCount, dev);
        hipFuncSetAttribute((const void*)mega, hipFuncAttributeMaxDynamicSharedMemorySize, LDS_BYTES);
        hipOccupancyMaxActiveBlocksPerMultiprocessor(&per_cu, (const void*)mega, 512, LDS_BYTES);
        if (per_cu < 1) { fprintf(stderr, "kernel_launch: occupancy query says %d blocks per CU\n", per_cu); per_cu = 1; }
        (void)hipGetLastError();
        grid_blocks = cus;
        if (n_in != 37 || ws_size < WS_NEED) fprintf(stderr, "kernel_launch: unexpected n_in %d or ws_size %zu (< %zu)\n", n_in, ws_size, (size_t)WS_NEED);
    }
    Params p{};
    for (int i = 0; i < 37; ++i) p.in[i] = (const float*)d_in[i];
    p.out = (float*)d_out; p.ws = (unsigned char*)d_ws;
    void* args[] = {&p};
    hipError_t e = hipLaunchCooperativeKernel((const void*)mega, dim3(grid_blocks), dim3(512), args, LDS_BYTES, stream);
    if (e != hipSuccess) fprintf(stderr, "cooperative launch failed: %s (grid %d)\n", hipGetErrorString(e), grid_blocks);
}
```

```cpp
#include <hip/hip_runtime.h>
#include <hip/hip_cooperative_groups.h>
#include <cstdio>
namespace cg = cooperative_groups;

#define LAS __attribute__((address_space(3)))
typedef unsigned short bf16_t;
typedef short bf16x8 __attribute__((ext_vector_type(8)));
typedef float f32x4 __attribute__((ext_vector_type(4)));
typedef float f32x2 __attribute__((ext_vector_type(2)));
typedef unsigned u32x4 __attribute__((ext_vector_type(4)));
typedef unsigned u32x2 __attribute__((ext_vector_type(2)));

constexpr int NTOK = 16384, DM = 1024, NPROMPT = 8192;
constexpr int LDS_BYTES = 147456;
constexpr size_t MiB = 1ull << 20;
constexpr size_t W_INAB = 0, W_GLU = 4 * MiB, W_INCD = 0, W_GATE = 5 * MiB, W_OUT = 8 * MiB, W_UP = 10 * MiB, W_DOWN = 21 * MiB;
constexpr size_t WS_H = 28 * MiB, WS_AR = 60 * MiB, WS_MISC = 236 * MiB, WS_NEED = 238 * MiB, M_ST = WS_MISC + 1536 * 1024;
constexpr size_t A_U = WS_AR, A_A2 = WS_AR + 88 * MiB, A_Y = WS_AR;
constexpr size_t A_AB = WS_AR, A_E = WS_AR + 32 * MiB, A_Q = WS_AR + 64 * MiB, A_KP = WS_AR + 80 * MiB, A_KS = WS_AR + 88 * MiB,
                 A_VTP = WS_AR + 98 * MiB, A_VTS = WS_AR + 106 * MiB, A_HCAT = WS_AR + 116 * MiB, A_WB = WS_AR + 120 * MiB, A_YS = WS_AR + 128 * MiB;
constexpr size_t A_XIN = WS_AR, A_BG = WS_AR + 16 * MiB, A_CG = WS_AR + 32 * MiB, A_XR = WS_AR + 48 * MiB, A_GB = WS_AR + 64 * MiB,
                 A_XC = WS_AR + 80 * MiB, A_HF = WS_AR + 96 * MiB, A_LA = WS_AR, A_BV = WS_AR + 32 * MiB;
constexpr size_t M_MOD = WS_MISC, M_ROPE = WS_MISC + 256 * 1024, M_SCAL = WS_MISC + 768 * 1024, M_SP8 = WS_MISC + 772 * 1024;
constexpr size_t O_K = 16777216, O_V = 20971520, O_S5 = 25165824, O_LRU = 25427968;

struct Params { const float* in[37]; float* out; unsigned char* ws; };
constexpr size_t WS_MISC_ = 236ull << 20;
constexpr int TAB_OFF = 143360;
struct Ctx { const LAS unsigned long long* tab;
    __device__ __forceinline__ unsigned long long ld(int i) const {
        const unsigned long long v = tab[i];
        const unsigned lo = __builtin_amdgcn_readfirstlane((unsigned)v), hi = __builtin_amdgcn_readfirstlane((unsigned)(v >> 32));
        return ((unsigned long long)hi << 32) | lo; }
    __device__ __forceinline__ const float* in(int i) const { return (const float*)(const __attribute__((address_space(1))) float*)ld(i); }
    __device__ __forceinline__ float* out() const { return (float*)(__attribute__((address_space(1))) float*)ld(37); }
    __device__ __forceinline__ unsigned char* ws() const { return (unsigned char*)(__attribute__((address_space(1))) unsigned char*)ld(38); }
    __device__ __forceinline__ unsigned* xbarp() const { return (unsigned*)(__attribute__((address_space(1))) unsigned char*)ld(38) + (WS_MISC_ + 900 * 1024) / 4; }
    __device__ __forceinline__ unsigned* barp() const { return (unsigned*)(__attribute__((address_space(1))) unsigned char*)ld(38) + (WS_MISC_ + 800 * 1024) / 4; } };
__device__ __forceinline__ int otid() { int t = threadIdx.x; asm volatile("" : "+v"(t)); return t; }

__device__ __forceinline__ unsigned cvt_pk_bf16(float lo, float hi) { unsigned r; asm("v_cvt_pk_bf16_f32 %0, %1, %2" : "=v"(r) : "v"(lo), "v"(hi)); return r; }
__device__ __forceinline__ bf16_t f2bf(float f) { return (bf16_t)(cvt_pk_bf16(f, 0.f) & 0xffffu); }
__device__ __forceinline__ float bf2f(bf16_t b) { return __uint_as_float(((unsigned)b) << 16); }
__device__ __forceinline__ float bflo(unsigned w) { return __uint_as_float(w << 16); }
__device__ __forceinline__ float bfhi(unsigned w) { return __uint_as_float(w & 0xffff0000u); }
__device__ __forceinline__ float sigmoidf_(float x) { return __builtin_amdgcn_rcpf(1.0f + __builtin_amdgcn_exp2f(-1.4426950408889634f * x)); }
__device__ __forceinline__ float gelu_t(float x) { const float z = -2.302208198f * (x + 0.044715f * x * x * x); return x * __builtin_amdgcn_rcpf(1.0f + __builtin_amdgcn_exp2f(z)); }
typedef unsigned u32x2s __attribute__((ext_vector_type(2)));
__device__ __forceinline__ float sum_xor32(float v) { const u32x2s r = __builtin_amdgcn_permlane32_swap(__float_as_uint(v), __float_as_uint(v), false, false); return __uint_as_float(r[0]) + __uint_as_float(r[1]); }
__device__ __forceinline__ float sum_xor16(float v) { const u32x2s r = __builtin_amdgcn_permlane16_swap(__float_as_uint(v), __float_as_uint(v), false, false); return __uint_as_float(r[0]) + __uint_as_float(r[1]); }
__device__ __forceinline__ float wave_sum(float v) { for (int o = 32; o >= 1; o >>= 1) v += __shfl_xor(v, o); return v; }
__device__ __forceinline__ void unpack8(const u32x4 w, float (&v)[8]) { v[0] = bflo(w.x); v[1] = bfhi(w.x); v[2] = bflo(w.y); v[3] = bfhi(w.y); v[4] = bflo(w.z); v[5] = bfhi(w.z); v[6] = bflo(w.w); v[7] = bfhi(w.w); }

namespace pg8 {
constexpr int BM = 256, BK = 64, HALF = 128, HTB = HALF * BK * 2, NXCD = 8, WGM = 8;
__device__ __forceinline__ int lds_byte(int r, int c) { const int st = (r >> 4) * 2 + (c >> 5), rr = r & 15, cc = c & 31, ob = rr * 64 + cc * 2; return st * 1024 + (ob ^ (((ob >> 9) & 1) << 5)); }
__device__ __forceinline__ void stage_rc(int b, int& R, int& C) { const int st = b / 1024, sb = b % 1024, swz = sb ^ (((sb >> 9) & 1) << 5); R = (st >> 1) * 16 + swz / 64; C = (st & 1) * 32 + (swz % 64) / 2; }
__device__ __forceinline__ int perm32(int rho) { const int n = rho >> 4, i = rho & 15; return 8 * (i >> 2) + 4 * n + (i & 3); }
struct Unit { int pm, pn; };
struct Gemm { const bf16_t* A; const bf16_t* Bt; int lda, ldb, K; };
struct StaticOrder {
    int nM, nN, nwg, G, c;
    __device__ void init(int M, int N, int G_, int c_) { nM = M / BM; nN = N / BM; nwg = nM * nN; G = G_; c = c_; }
    __device__ bool next(int i, Unit& u) const {
        const long L = (long)i * G + c; if (L >= nwg) return false;
        int wgid = (int)L; { const int q = nwg / NXCD, r = nwg % NXCD, xcd = wgid % NXCD, off = wgid / NXCD; wgid = (xcd < r ? xcd * (q + 1) : r * (q + 1) + (xcd - r) * q) + off; }
        const int nig = WGM * nN, gid = wgid / nig, fm = gid * WGM, gsz = (nM - fm) < WGM ? (nM - fm) : WGM;
        u.pm = fm + ((wgid % nig) % gsz); u.pn = (wgid % nig) / gsz; return true;
    }
    __device__ __forceinline__ size_t aoff(const Unit& u, size_t tstepA, int lda) const { return (size_t)u.pm * tstepA; }
    __device__ __forceinline__ size_t boff(const Unit& u, size_t tstepB) const { return (size_t)u.pn * tstepB; }
};
struct GateOrder : StaticOrder {
    __device__ __forceinline__ size_t aoff(const Unit& u, size_t tstepA, int lda) const { return (size_t)u.pm * tstepA + (size_t)(((u.pn & 3) >> 1) * 256) * 2; }
    __device__ __forceinline__ size_t boff(const Unit& u, size_t tstepB) const { return (size_t)u.pn * tstepB + (size_t)(((u.pn & 3) >> 1) * 256) * 2; }
};
struct FfnOrder : StaticOrder {
    __device__ void init2(int G_, int c_) { nM = 68; nN = 22; nwg = 68 * 22; G = G_; c = c_; }
    __device__ __forceinline__ size_t aoff(const Unit& u, size_t tstepA, int lda) const {
        const int q = u.pm - 32; const int sb = q / 9, k = q - 9 * sb;
        const long tok = u.pm < 32 ? 256 * u.pm : 8192 + 2048 * sb + 254 * k - 1;
        return (size_t)(tok * lda * 2); }
};
struct S5Order {
    int G, c;
    __device__ bool next(int i, Unit& u) const { const int L = i * G + c; if (L >= 128) return false; u.pm = L; u.pn = L >> 2; return true; }
    __device__ __forceinline__ size_t aoff(const Unit& u, size_t tstepA, int lda) const { return (size_t)u.pm * tstepA; }
    __device__ __forceinline__ size_t boff(const Unit& u, size_t tstepB) const { return (size_t)u.pn * tstepB; }
};

template <class Epi, class Sched>
__device__ __forceinline__ void gemm_phase(LAS unsigned char* lds, const Gemm g, const Sched& S, const Epi& E) {
    int tid_ = threadIdx.x; asm volatile("" : "+v"(tid_));
    const int tid = tid_, wid = __builtin_amdgcn_readfirstlane(tid >> 6), lane = tid & 63, wr = wid >> 2, wc = wid & 3, fr = lane & 15, fq = lane >> 4;
    const int K = g.K, nt = K / BK;
    unsigned voffA[2], voffB[2];
#pragma unroll
    for (int i = 0; i < 2; ++i) { int R, C; stage_rc(tid * 16 + i * 8192, R, C); const int Rb = Epi::PERM ? ((R & ~31) + perm32(R & 31)) : R;
        const int Ra = Epi::ROWPERM ? (128 * (R >> 6) + 8 * (R & 15) + ((R >> 4) & 3)) : R;
        voffA[i] = (unsigned)(Ra * g.lda + C) * 2u; voffB[i] = (unsigned)(Rb * g.ldb + C) * 2u; }
    const size_t kstep = (size_t)(BK * 2);
    const size_t hstepA = Epi::ROWPERM ? (size_t)4 * g.lda * 2 : (size_t)HALF * g.lda * 2, hstepB = (size_t)HALF * g.ldb * 2;
    const size_t tstepA = (size_t)BM * g.lda * 2, tstepB = 2 * hstepB;
    const unsigned ldsw = (unsigned)wid * 1024u;
    const int aoff = lds_byte(wr * 64 + fr, fq * 8), boff = lds_byte(wc * 32 + fr, fq * 8);
#define PG8_SA(b, h) (((b) * 2 + (h)) * HTB)
#define PG8_SB(b, h) ((4 + (b) * 2 + (h)) * HTB)
#define PG8_STAGE(bufoff, gbase, voff) do { _Pragma("unroll") for (int _i = 0; _i < 2; ++_i) \
        __builtin_amdgcn_global_load_lds((const unsigned*)((const char*)(gbase) + (voff)[_i]), (LAS unsigned*)(lds + (bufoff) + ldsw + _i * 8192), 16, 0, 0); } while (0)
#define PG8_LDA(dst, b, h) do { _Pragma("unroll") for (int m = 0; m < 4; ++m) _Pragma("unroll") for (int k = 0; k < 2; ++k) dst[m][k] = *(const LAS bf16x8*)(lds + PG8_SA(b, h) + aoff + m * 2048 + k * 1024); } while (0)
#define PG8_LDB(dst, b, h) do { _Pragma("unroll") for (int n = 0; n < 2; ++n) _Pragma("unroll") for (int k = 0; k < 2; ++k) dst[n][k] = *(const LAS bf16x8*)(lds + PG8_SB(b, h) + boff + n * 2048 + k * 1024); } while (0)
#define PG8_MMA(ai, bj, At, Bt) do { __builtin_amdgcn_s_setprio(1); _Pragma("unroll") for (int m = 0; m < 4; ++m) _Pragma("unroll") for (int n = 0; n < 2; ++n) _Pragma("unroll") for (int k = 0; k < 2; ++k) \
        acc[ai][bj][m][n] = __builtin_amdgcn_mfma_f32_16x16x32_bf16(Bt[n][k], At[m][k], acc[ai][bj][m][n], 0, 0, 0); __builtin_amdgcn_s_setprio(0); } while (0)
#define PG8_WAIT_V(n) asm volatile("s_waitcnt vmcnt(" #n ")" ::: "memory")
#define PG8_WAIT_L(n) asm volatile("s_waitcnt lgkmcnt(" #n ")" ::: "memory")
#define PG8_BAR __builtin_amdgcn_s_barrier()
#define PG8_SCHED __builtin_amdgcn_sched_barrier(0)
    Unit cur, nxt; int ui = 0;
    if (!S.next(0, cur)) return;
    f32x4 acc[2][2][4][2];
#pragma unroll
    for (int a = 0; a < 2; ++a)
#pragma unroll
        for (int b = 0; b < 2; ++b)
#pragma unroll
            for (int m = 0; m < 4; ++m)
#pragma unroll
                for (int n = 0; n < 2; ++n) acc[a][b][m][n] = (f32x4){0.f, 0.f, 0.f, 0.f};
    bf16x8 At[4][2], B0[2][2], B1[2][2];
    const char* cA = (const char*)g.A + S.aoff(cur, tstepA, g.lda); const char* cB = (const char*)g.Bt + S.boff(cur, tstepB);
    PG8_STAGE(PG8_SB(0, 0), cB, voffB); PG8_STAGE(PG8_SA(0, 0), cA, voffA); PG8_STAGE(PG8_SB(0, 1), cB + hstepB, voffB); PG8_STAGE(PG8_SA(0, 1), cA + hstepA, voffA);
    if (wr == 1) PG8_BAR;
    PG8_WAIT_V(4); PG8_BAR;
    PG8_STAGE(PG8_SB(1, 0), cB + kstep, voffB); PG8_STAGE(PG8_SA(1, 0), cA + kstep, voffA); PG8_STAGE(PG8_SB(1, 1), cB + hstepB + kstep, voffB);
    PG8_WAIT_V(6); PG8_BAR;
    for (;;) {
        const bool has_next = S.next(ui + 1, nxt);
        const char* nA = has_next ? (const char*)g.A + S.aoff(nxt, tstepA, g.lda) : cA; const char* nB = has_next ? (const char*)g.Bt + S.boff(nxt, tstepB) : cB;
        for (int t = 0; t < nt; t += 2) {
            const bool last = (t == nt - 2);
            const char* a1 = cA + (size_t)(t + 1) * kstep;
            const char* a2 = last ? nA : cA + (size_t)(t + 2) * kstep; const char* b2 = last ? nB : cB + (size_t)(t + 2) * kstep;
            const char* a3 = a2 + kstep; const char* b3 = b2 + kstep;
            PG8_LDB(B0, 0, 0); PG8_SCHED; PG8_LDA(At, 0, 0); PG8_STAGE(PG8_SA(1, 1), a1 + hstepA, voffA);
            PG8_WAIT_L(8); PG8_BAR; PG8_WAIT_L(0); PG8_MMA(0, 0, At, B0); PG8_BAR; PG8_SCHED;
            PG8_LDB(B1, 0, 1); PG8_STAGE(PG8_SB(0, 0), b2, voffB);
            PG8_BAR; PG8_WAIT_L(0); PG8_MMA(0, 1, At, B1); PG8_BAR;
            PG8_LDA(At, 0, 1); PG8_STAGE(PG8_SA(0, 0), a2, voffA);
            PG8_BAR; PG8_WAIT_L(0); PG8_MMA(1, 0, At, B0); PG8_BAR; PG8_SCHED;
            PG8_STAGE(PG8_SB(0, 1), b2 + hstepB, voffB);
            PG8_WAIT_V(6); PG8_BAR; PG8_MMA(1, 1, At, B1); PG8_BAR;
            PG8_LDB(B0, 1, 0); PG8_SCHED; PG8_LDA(At, 1, 0); PG8_STAGE(PG8_SA(0, 1), a2 + hstepA, voffA);
            PG8_WAIT_L(8); PG8_BAR; PG8_WAIT_L(0); PG8_MMA(0, 0, At, B0); PG8_BAR; PG8_SCHED;
            PG8_LDB(B1, 1, 1); PG8_STAGE(PG8_SB(1, 0), b3, voffB);
            PG8_BAR; PG8_WAIT_L(0); PG8_MMA(0, 1, At, B1); PG8_BAR;
            PG8_LDA(At, 1, 1); PG8_STAGE(PG8_SA(1, 0), a3, voffA);
            PG8_BAR; PG8_WAIT_L(0); PG8_MMA(1, 0, At, B0); PG8_BAR; PG8_SCHED;
            PG8_STAGE(PG8_SB(1, 1), b3 + hstepB, voffB);
            PG8_WAIT_V(6); PG8_BAR; PG8_MMA(1, 1, At, B1); PG8_BAR;
        }
        if constexpr (Epi::AFTER_DRAIN) {} else if constexpr (Epi::ROWPERM) E.fused(acc, cur, wr, wc, fr, fq, lds); else E(acc, cur, wr, wc, fr, fq);
        if (!has_next) break;
#pragma unroll
        for (int a = 0; a < 2; ++a)
#pragma unroll
            for (int b = 0; b < 2; ++b)
#pragma unroll
                for (int m = 0; m < 4; ++m)
#pragma unroll
                    for (int n = 0; n < 2; ++n) acc[a][b][m][n] = (f32x4){0.f, 0.f, 0.f, 0.f};
        cur = nxt; cA = nA; cB = nB; ++ui;
    }
    PG8_WAIT_V(0);
    if (wr == 0) PG8_BAR;
    PG8_BAR;
    if constexpr (Epi::AFTER_DRAIN) E.drain(acc, cur, wr, wc, fr, fq, lds);
#undef PG8_SA
#undef PG8_SB
#undef PG8_STAGE
#undef PG8_LDA
#undef PG8_LDB
#undef PG8_MMA
#undef PG8_WAIT_V
#undef PG8_WAIT_L
#undef PG8_BAR
#undef PG8_SCHED
}

typedef const f32x4 (&AccT)[2][2][4][2];

template <bool NOPN> struct EpiF32 {
    static constexpr bool PERM = false, ROWPERM = false, AFTER_DRAIN = false;
    float* C; int ldc;
    __device__ __forceinline__ void operator()(AccT acc, const Unit& u, int wr, int wc, int fr, int fq) const {
        const int row0 = u.pm * BM + wr * 64 + fr, col0 = (NOPN ? 0 : u.pn * BM) + wc * 32 + 4 * fq;
#pragma unroll
        for (int ai = 0; ai < 2; ++ai)
#pragma unroll
            for (int m = 0; m < 4; ++m) { float* rowp = C + (size_t)(row0 + ai * HALF + m * 16) * ldc + col0;
#pragma unroll
                for (int bj = 0; bj < 2; ++bj)
#pragma unroll
                    for (int n = 0; n < 2; ++n) *(f32x4*)(rowp + bj * HALF + n * 16) = acc[ai][bj][m][n]; }
    }
};
struct EpiBf16 {
    static constexpr bool PERM = true, ROWPERM = false, AFTER_DRAIN = false;
    bf16_t* O; int ldc; int tpb; size_t bufstride;
    __device__ __forceinline__ void operator()(AccT acc, const Unit& u, int wr, int wc, int fr, int fq) const {
        const int row0 = u.pm * BM + wr * 64 + fr; const int bsel = u.pn / tpb; const int col0 = (u.pn - bsel * tpb) * BM + wc * 32 + 8 * fq;
        bf16_t* base = O + (size_t)bsel * bufstride;
#pragma unroll
        for (int ai = 0; ai < 2; ++ai)
#pragma unroll
            for (int m = 0; m < 4; ++m) { bf16_t* rowp = base + (size_t)(row0 + ai * HALF + m * 16) * ldc + col0;
#pragma unroll
                for (int bj = 0; bj < 2; ++bj) { const f32x4 v0 = acc[ai][bj][m][0], v1 = acc[ai][bj][m][1];
                    u32x4 w; w.x = cvt_pk_bf16(v0[0], v0[1]); w.y = cvt_pk_bf16(v0[2], v0[3]); w.z = cvt_pk_bf16(v1[0], v1[1]); w.w = cvt_pk_bf16(v1[2], v1[3]);
                    *(u32x4*)(rowp + bj * HALF) = w; } }
    }
};
struct EpiInAB {
    static constexpr bool PERM = false, ROWPERM = false, AFTER_DRAIN = false;
    bf16_t *AB, *Q, *KP, *KS, *VTP, *VTS; float *outK, *outV; const f32x2* rope;
    __device__ __forceinline__ void operator()(AccT acc, const Unit& u, int wr, int wc, int fr, int fq) const {
        const int sec = u.pn >> 1;
        const int cbase = (u.pn & 1) * 256 + wc * 32 + 4 * fq;
        const bool samp = u.pm >= 32;
#pragma unroll
        for (int ai = 0; ai < 2; ++ai)
#pragma unroll
            for (int m = 0; m < 4; ++m) {
                const int row = u.pm * BM + ai * HALF + wr * 64 + m * 16 + fr;
                if (sec == 0) {
                    const int j = row >> 4, s = row & 15;
#pragma unroll
                    for (int bj = 0; bj < 2; ++bj)
#pragma unroll
                        for (int n = 0; n < 2; ++n) { const int c = cbase + bj * HALF + n * 16; const int g = c >> 4, q0 = c & 15; const f32x4 v = acc[ai][bj][m][n];
                            u32x2 w; w.x = cvt_pk_bf16(v[0], v[1]); w.y = cvt_pk_bf16(v[2], v[3]);
                            *(u32x2*)(AB + ((size_t)(g * 1024 + j) * 512 + s * 16 + q0)) = w; }
                } else if (sec == 3) {
                    const int b = samp ? ((row - NPROMPT) >> 11) : (row >> 8); const int t = samp ? ((row - NPROMPT) & 2047) : (row & 255);
                    const int Lk = samp ? 2560 : 256; bf16_t* vt = samp ? VTS : VTP;
#pragma unroll
                    for (int bj = 0; bj < 2; ++bj)
#pragma unroll
                        for (int n = 0; n < 2; ++n) { const int c = cbase + bj * HALF + n * 16; const f32x4 v = acc[ai][bj][m][n];
                            if (!samp) *(f32x4*)(outV + (size_t)row * 512 + c) = v;
                            const int h = c >> 7, dv = c & 127; bf16_t* dst = vt + ((size_t)((b * 4 + h) * 128 + dv)) * Lk + t;
                            dst[0] = f2bf(v[0]); dst[Lk] = f2bf(v[1]); dst[2 * Lk] = f2bf(v[2]); dst[3 * Lk] = f2bf(v[3]); }
                } else {
                    const int t = (row - NPROMPT) & 2047; const int sb = (row - NPROMPT) >> 11;
#pragma unroll
                    for (int bj = 0; bj < 2; ++bj) {
                        f32x4 v0 = acc[ai][bj][m][0], v1 = acc[ai][bj][m][1];
                        const int c = cbase + bj * HALF;
                        if (samp) {
                            const f32x2* rp = rope + ((size_t)(t * 2 + (wc & 1)) * 16 + 4 * fq);
                            const f32x4 r01 = *(const f32x4*)rp, r23 = *(const f32x4*)(rp + 2);
                            const float cs[4] = {r01[0], r01[2], r23[0], r23[2]}, sn[4] = {r01[1], r01[3], r23[1], r23[3]};
                            f32x4 o0, o1;
#pragma unroll
                            for (int i = 0; i < 4; ++i) { o0[i] = v0[i] * cs[i] - v1[i] * sn[i]; o1[i] = v1[i] * cs[i] + v0[i] * sn[i]; }
                            v0 = o0; v1 = o1;
                        }
                        u32x2 w0, w1; w0.x = cvt_pk_bf16(v0[0], v0[1]); w0.y = cvt_pk_bf16(v0[2], v0[3]); w1.x = cvt_pk_bf16(v1[0], v1[1]); w1.y = cvt_pk_bf16(v1[2], v1[3]);
                        if (sec == 1) { bf16_t* dst = Q + (size_t)row * 512 + c; *(u32x2*)dst = w0; *(u32x2*)(dst + 16) = w1; }
                        else if (!samp) { float* ok = outK + (size_t)row * 512 + c; *(f32x4*)ok = v0; *(f32x4*)(ok + 16) = v1;
                            bf16_t* dst = KP + (size_t)row * 512 + c; *(u32x2*)dst = w0; *(u32x2*)(dst + 16) = w1; }
                        else { bf16_t* dst = KS + ((size_t)(sb * 2560 + t)) * 512 + c; *(u32x2*)dst = w0; *(u32x2*)(dst + 16) = w1; }
                    }
                }
            }
    }
};
struct EpiS5B {
    static constexpr bool PERM = false, ROWPERM = false, AFTER_DRAIN = false;
    bf16_t* YS;
    __device__ __forceinline__ void operator()(AccT acc, const Unit& u, int wr, int wc, int fr, int fq) const {
        const int g = u.pn;
#pragma unroll
        for (int ai = 0; ai < 2; ++ai)
#pragma unroll
            for (int m = 0; m < 4; ++m) { const int j = (u.pm & 3) * BM + ai * HALF + wr * 64 + m * 16 + fr;
#pragma unroll
                for (int bj = 0; bj < 2; ++bj)
#pragma unroll
                    for (int n = 0; n < 2; ++n) { const int t = 8 * bj + 2 * wc + n; const f32x4 v = acc[ai][bj][m][n];
                        u32x2 w; w.x = cvt_pk_bf16(gelu_t(v[0]), gelu_t(v[1])); w.y = cvt_pk_bf16(gelu_t(v[2]), gelu_t(v[3]));
                        *(u32x2*)(YS + (size_t)(16 * j + t) * 512 + 16 * g + 4 * fq) = w; } }
    }
};
struct EpiGLU {
    static constexpr bool PERM = true, ROWPERM = false, AFTER_DRAIN = false;
    const bf16_t* YS; bf16_t* CAT; const float* bias;
    __device__ __forceinline__ void operator()(AccT acc, const Unit& u, int wr, int wc, int fr, int fq) const {
        const int row0 = u.pm * BM + wr * 64 + fr, col0 = u.pn * BM + wc * 32 + 8 * fq;
        f32x4 b0[2], b1[2];
#pragma unroll
        for (int bj = 0; bj < 2; ++bj) { const int c = col0 + bj * HALF; b0[bj] = *(const f32x4*)(bias + c); b1[bj] = *(const f32x4*)(bias + c + 4); }
#pragma unroll
        for (int ai = 0; ai < 2; ++ai) {
            u32x4 yw[1][4][2];
#pragma unroll
            for (int bj = 0; bj < 2; ++bj)
#pragma unroll
                for (int m = 0; m < 4; ++m) yw[0][m][bj] = *(const u32x4*)(YS + (size_t)(row0 + ai * HALF + m * 16) * 512 + col0 + bj * HALF);
#pragma unroll
            for (int m = 0; m < 4; ++m) { const int row = row0 + ai * HALF + m * 16;
#pragma unroll
                for (int bj = 0; bj < 2; ++bj) { const int c = col0 + bj * HALF;
                    float y[8]; unpack8(yw[0][m][bj], y);
                    const f32x4 v0 = acc[ai][bj][m][0] + b0[bj], v1 = acc[ai][bj][m][1] + b1[bj];
                    float o[8];
#pragma unroll
                    for (int i = 0; i < 4; ++i) { o[i] = y[i] * sigmoidf_(v0[i]); o[4 + i] = y[4 + i] * sigmoidf_(v1[i]); }
                    u32x4 w; w.x = cvt_pk_bf16(o[0], o[1]); w.y = cvt_pk_bf16(o[2], o[3]); w.z = cvt_pk_bf16(o[4], o[5]); w.w = cvt_pk_bf16(o[6], o[7]);
                    *(u32x4*)(CAT + (size_t)row * 1024 + c) = w; } }
            asm volatile("" ::: "memory"); }
    }
};
struct EpiGate {
    static constexpr bool PERM = false, ROWPERM = false, AFTER_DRAIN = false;
    const bf16_t* XC; bf16_t *LA, *BV; const float *ba, *bx, *sp8;
    __device__ __forceinline__ void operator()(AccT acc, const Unit& u, int wr, int wc, int fr, int fq) const {
        const int d = u.pn >> 2;
#pragma unroll
        for (int bj = 0; bj < 2; ++bj) { const int ch = 16 * (8 * (u.pn & 3) + 4 * bj + wc) + 4 * fq;
            const f32x4 va = *(const f32x4*)(ba + d * 512 + ch), vx = *(const f32x4*)(bx + d * 512 + ch), vs = *(const f32x4*)(sp8 + d * 512 + ch);
#pragma unroll
            for (int ai = 0; ai < 2; ++ai) {
                u32x2 xw[4];
#pragma unroll
                for (int m = 0; m < 4; ++m) { const int row = u.pm * BM + ai * HALF + wr * 64 + m * 16 + fr; xw[m] = *(const u32x2*)(XC + (size_t)row * 512 + ch); }
#pragma unroll
                for (int m = 0; m < 4; ++m) { const int row = u.pm * BM + ai * HALF + wr * 64 + m * 16 + fr;
                    const float xc[4] = {bflo(xw[m].x), bfhi(xw[m].x), bflo(xw[m].y), bfhi(xw[m].y)};
                    const f32x4 pr = acc[ai][bj][m][0] + va, pi = acc[ai][bj][m][1] + vx;
                    float la[4], bv[4];
#pragma unroll
                    for (int i = 0; i < 4; ++i) { const float r = sigmoidf_(pr[i]), ig = sigmoidf_(pi[i]); la[i] = -r * vs[i];
                        const float om = fmaxf(1.0f - __builtin_amdgcn_exp2f(2.885390082f * la[i]), 0.f);
                        bv[i] = __builtin_amdgcn_sqrtf(om) * (ig * xc[i]); }
                    u32x2 wl, wb; wl.x = cvt_pk_bf16(la[0], la[1]); wl.y = cvt_pk_bf16(la[2], la[3]); wb.x = cvt_pk_bf16(bv[0], bv[1]); wb.y = cvt_pk_bf16(bv[2], bv[3]);
                    const size_t off = ((size_t)d * NTOK + row) * 512 + ch;
                    *(u32x2*)(LA + off) = wl; *(u32x2*)(BV + off) = wb; }
                asm volatile("" ::: "memory"); } }
    }
};
__device__ __forceinline__ float dpp_shr1(float v) { return __builtin_bit_cast(float, __builtin_amdgcn_update_dpp(0, __builtin_bit_cast(int, v), 0x111, 0xf, 0xf, true)); }
__device__ __forceinline__ float dpp_shl1(float v) { return __builtin_bit_cast(float, __builtin_amdgcn_update_dpp(0, __builtin_bit_cast(int, v), 0x101, 0xf, 0xf, true)); }
struct EpiFfnUp {
    static constexpr bool PERM = false, ROWPERM = true, AFTER_DRAIN = false;
    bf16_t* A2; const float* cw; const float* cb;
    __device__ __forceinline__ void fused(f32x4 (&acc)[2][2][4][2], const Unit& u, int wr, int wc, int fr, int fq, LAS unsigned char* lds) const {
        LAS float* xch = (LAS float*)(lds + 131072);
        if ((wr == 0) ? (fr == 15) : (fr == 0)) { LAS float* dst = xch + ((wc * 2 + wr) * 4 + fq) * 16;
#pragma unroll
            for (int bj = 0; bj < 2; ++bj)
#pragma unroll
                for (int n = 0; n < 2; ++n) *(LAS f32x4*)(dst + (bj * 2 + n) * 4) = (wr == 0) ? acc[1][bj][3][n] : acc[0][bj][0][n]; }
        asm volatile("s_waitcnt lgkmcnt(0)" ::: "memory"); __builtin_amdgcn_s_barrier(); asm volatile("" ::: "memory");
        if (wr == 0) { __builtin_amdgcn_s_barrier(); asm volatile("" ::: "memory"); }
        const LAS float* xsp = xch + ((wc * 2 + (1 - wr)) * 4 + fq) * 16;
        const bool samp = u.pm >= 32; const int q = u.pm - 32; const int sb = q / 9, k = q - 9 * sb;
        const int tstart = samp ? 254 * k - 1 : 0, L = samp ? 2048 : 256, olo = samp ? 1 : 0, ohi = samp ? 254 : 255;
        const size_t rowbase = samp ? (size_t)(8192 + 2048 * sb) : (size_t)(256 * u.pm);
        const int o0 = 128 * wr + 8 * fr;
        const int cch0 = 128 * u.pn + 32 * wc + 4 * fq;
        const f32x4 z = (f32x4){0.f, 0.f, 0.f, 0.f};
#pragma unroll
        for (int n = 0; n < 2; ++n) {
            const int cch = cch0 + 16 * n;
#pragma unroll
            for (int bj = 0; bj < 2; ++bj) {
                const float* wp = cw + bj * 2816 + cch;
                const f32x4 w0 = *(const f32x4*)wp, w1 = *(const f32x4*)(wp + 5632), w2 = *(const f32x4*)(wp + 2 * 5632), bb = *(const f32x4*)(cb + bj * 2816 + cch);
                f32x4 prev, nx;
#pragma unroll
                for (int i = 0; i < 4; ++i) { prev[i] = dpp_shr1(acc[1][bj][3][n][i]); nx[i] = dpp_shl1(acc[0][bj][0][n][i]); }
                { const f32x4 xp = *(const LAS f32x4*)(xsp + (bj * 2 + n) * 4); if (fr == 0) prev = xp; if (fr == 15) nx = xp; }
#pragma unroll
                for (int e = 0; e < 8; ++e) {
                    const int o = o0 + e, t = tstart + o;
                    const bool lok = t >= 1, rok = t <= L - 2, ook = (o >= olo) && (o <= ohi) && (t >= 0) && (t < L);
                    const f32x4 cur = acc[e >> 2][bj][e & 3][n];
                    const f32x4 nxt = e == 7 ? nx : acc[((e + 1) >> 2) & 1][bj][(e + 1) & 3][n];
                    const f32x4 lft = (e <= 1) ? (lok ? prev : z) : prev, rgt = (e == 0 || e == 7) ? (rok ? nxt : z) : nxt;
                    const f32x4 uu = bb + w0 * lft + w1 * cur + w2 * rgt;
                    prev = cur;
                    if (bj == 0) { const f32x4 zz = uu * (uu * uu * (-0.102943240f) + (-2.302208198f));
                        f32x4 dd; dd[0] = __builtin_amdgcn_exp2f(zz[0]); dd[1] = __builtin_amdgcn_exp2f(zz[1]); dd[2] = __builtin_amdgcn_exp2f(zz[2]); dd[3] = __builtin_amdgcn_exp2f(zz[3]);
                        dd = dd + 1.0f; f32x4 rr; rr[0] = __builtin_amdgcn_rcpf(dd[0]); rr[1] = __builtin_amdgcn_rcpf(dd[1]); rr[2] = __builtin_amdgcn_rcpf(dd[2]); rr[3] = __builtin_amdgcn_rcpf(dd[3]);
                        acc[e >> 2][0][e & 3][n] = uu * rr; }
                    else { const f32x4 gv = acc[e >> 2][0][e & 3][n]; u32x2 pk; pk.x = cvt_pk_bf16(gv[0] * uu[0], gv[1] * uu[1]); pk.y = cvt_pk_bf16(gv[2] * uu[2], gv[3] * uu[3]);
                        if (ook) *(u32x2*)(A2 + (rowbase + t) * 2816 + cch) = pk; }
                }
                __builtin_amdgcn_sched_barrier(0);
            }
        }
        if (wr != 0) { asm volatile("" ::: "memory"); __builtin_amdgcn_s_barrier(); asm volatile("" ::: "memory"); }
    }
};
struct EpiPost {
    static constexpr bool PERM = true, ROWPERM = false, AFTER_DRAIN = true;
    const float *xin0, *xin1; float* X; bf16_t* H; const float* MOD; const float* ng;
    int from_input, lpost, jpost, has_pre, lpre, jpre; float* st; unsigned* cnt; unsigned expect;
    const bf16_t* xb_in; bf16_t* xb_out;
    __device__ __forceinline__ void rowstats(f32x4 (&v)[2][2][4][2], int stage, const Unit& u, int wr, int wc, int fr, int fq, LAS unsigned char* lds) const {
        LAS float* P = (LAS float*)lds; LAS float* S = (LAS float*)(lds + 4096);
        const int tid = otid();
#pragma unroll
        for (int ai = 0; ai < 2; ++ai)
#pragma unroll
            for (int m = 0; m < 4; ++m) { float s = 0.f;
#pragma unroll
                for (int bj = 0; bj < 2; ++bj)
#pragma unroll
                    for (int n = 0; n < 2; ++n) { const f32x4 x = v[ai][bj][m][n]; s += x[0] * x[0] + x[1] * x[1] + x[2] * x[2] + x[3] * x[3]; }
                s = sum_xor16(s); s = sum_xor32(s);
                if (fq == 0) P[(ai * HALF + wr * 64 + m * 16 + fr) * 4 + wc] = s; }
        __syncthreads();
        float* slot = st + ((size_t)(stage * NTOK + u.pm * BM)) * 4;
        if (tid < 256) { const float s = P[tid * 4] + P[tid * 4 + 1] + P[tid * 4 + 2] + P[tid * 4 + 3];
            __hip_atomic_store(slot + tid * 4 + u.pn, s, __ATOMIC_RELAXED, __HIP_MEMORY_SCOPE_AGENT); }
        asm volatile("s_waitcnt vmcnt(0)" ::: "memory");
        __syncthreads();
        if (tid == 0) { unsigned* c = cnt + (stage * 64 + u.pm) * 64;
            __hip_atomic_fetch_add(c, 1u, __ATOMIC_RELAXED, __HIP_MEMORY_SCOPE_AGENT);
            unsigned spins = 0;
            while (__hip_atomic_load(c, __ATOMIC_RELAXED, __HIP_MEMORY_SCOPE_AGENT) < expect && ++spins < (1u << 22)) __builtin_amdgcn_s_sleep(1);
            __builtin_amdgcn_fence(__ATOMIC_ACQUIRE, "agent");
            asm volatile("s_waitcnt vmcnt(0)" ::: "memory"); }
        __syncthreads();
        if (tid < 256) { float s = 0.f;
#pragma unroll
            for (int t = 0; t < 4; ++t) s += __hip_atomic_load(slot + tid * 4 + t, __ATOMIC_RELAXED, __HIP_MEMORY_SCOPE_AGENT);
            S[tid] = rsqrtf(s * (1.0f / 1024.0f) + 1e-6f); }
        __syncthreads();
    }
    __device__ __forceinline__ void drain(f32x4 (&acc)[2][2][4][2], const Unit& u, int wr, int wc, int fr, int fq, LAS unsigned char* lds) const {
        const LAS float* S = (const LAS float*)(lds + 4096);
        const int cv = u.pm < 32 ? 0 : 1 + ((u.pm - 32) >> 3);
        const int col0 = u.pn * BM + wc * 32 + 8 * fq;
        rowstats(acc, 0, u, wr, wc, fr, fq, lds);
        { const float* gp = ng + (lpost * 4 + (jpost ? 3 : 1)) * 1024 + col0; const float* gate = MOD + ((size_t)(lpost * 5 + cv) * 6 + 3 * jpost + 2) * 1024 + col0;
          f32x4 gg[2][2];
#pragma unroll
          for (int bj = 0; bj < 2; ++bj)
#pragma unroll
              for (int n = 0; n < 2; ++n) gg[bj][n] = *(const f32x4*)(gate + bj * HALF + 4 * n) * *(const f32x4*)(gp + bj * HALF + 4 * n);
          u32x4 xqa[2][4][2];
          if (!from_input) {
#pragma unroll
              for (int ai = 0; ai < 2; ++ai)
#pragma unroll
                  for (int m = 0; m < 4; ++m) { const int row = u.pm * BM + ai * HALF + wr * 64 + m * 16 + fr;
#pragma unroll
                      for (int bj = 0; bj < 2; ++bj) xqa[ai][m][bj] = *(const u32x4*)(xb_in + (size_t)row * DM + col0 + bj * HALF); } }
#pragma unroll
          for (int ai = 0; ai < 2; ++ai) {
#pragma unroll
              for (int m = 0; m < 4; ++m) { const int r = ai * HALF + wr * 64 + m * 16 + fr; const int row = u.pm * BM + r; const float rs = S[r];
                  const float* xr = (row < NPROMPT ? xin0 + (size_t)row * DM : xin1 + (size_t)(row - NPROMPT) * DM) + col0;
                  float* xw = X + (size_t)row * DM + col0;
#pragma unroll
                  for (int bj = 0; bj < 2; ++bj) { f32x4 xo0, xo1;
                      if (from_input) { xo0 = *(const f32x4*)(xr + bj * HALF); xo1 = *(const f32x4*)(xr + bj * HALF + 4); }
                      else { float t8[8]; unpack8(xqa[ai][m][bj], t8); xo0 = (f32x4){t8[0], t8[1], t8[2], t8[3]}; xo1 = (f32x4){t8[4], t8[5], t8[6], t8[7]}; }
                      const f32x4 xn0 = xo0 + gg[bj][0] * (acc[ai][bj][m][0] * rs), xn1 = xo1 + gg[bj][1] * (acc[ai][bj][m][1] * rs);
                      acc[ai][bj][m][0] = xn0; acc[ai][bj][m][1] = xn1;
                      if (xb_out) { u32x4 w; w.x = cvt_pk_bf16(xn0[0], xn0[1]); w.y = cvt_pk_bf16(xn0[2], xn0[3]); w.z = cvt_pk_bf16(xn1[0], xn1[1]); w.w = cvt_pk_bf16(xn1[2], xn1[3]);
                          *(u32x4*)(xb_out + (size_t)row * DM + col0 + bj * HALF) = w; }
                      else { *(f32x4*)(xw + bj * HALF) = xn0; *(f32x4*)(xw + bj * HALF + 4) = xn1; } }
                  if (from_input && (m & 1)) asm volatile("" ::: "memory"); }
              asm volatile("" ::: "memory"); } }
        if (has_pre) {
            rowstats(acc, 1, u, wr, wc, fr, fq, lds);
            const float* gq = ng + (lpre * 4 + (jpre ? 2 : 0)) * 1024 + col0; const float* sh = MOD + ((size_t)(lpre * 5 + cv) * 6 + 3 * jpre) * 1024 + col0; const float* sc = sh + 1024;
            f32x4 ga[2][2], sb[2][2];
#pragma unroll
            for (int bj = 0; bj < 2; ++bj)
#pragma unroll
                for (int n = 0; n < 2; ++n) { ga[bj][n] = *(const f32x4*)(gq + bj * HALF + 4 * n) * (1.0f + *(const f32x4*)(sc + bj * HALF + 4 * n)); sb[bj][n] = *(const f32x4*)(sh + bj * HALF + 4 * n); }
#pragma unroll
            for (int ai = 0; ai < 2; ++ai)
#pragma unroll
                for (int m = 0; m < 4; ++m) { const int r = ai * HALF + wr * 64 + m * 16 + fr; const int row = u.pm * BM + r; const float rs = S[r];
                    bf16_t* hw = H + (size_t)row * DM + col0;
#pragma unroll
                    for (int bj = 0; bj < 2; ++bj) { const f32x4 h0 = acc[ai][bj][m][0] * rs * ga[bj][0] + sb[bj][0], h1 = acc[ai][bj][m][1] * rs * ga[bj][1] + sb[bj][1];
                        u32x4 w; w.x = cvt_pk_bf16(h0[0], h0[1]); w.y = cvt_pk_bf16(h0[2], h0[3]); w.z = cvt_pk_bf16(h1[0], h1[1]); w.w = cvt_pk_bf16(h1[2], h1[3]);
                        *(u32x4*)(hw + bj * HALF) = w; } }
        }
        __syncthreads();
    }
};
}

constexpr size_t M_BAR = WS_MISC + 800 * 1024;
__device__ __forceinline__ void gbar(unsigned* bar, unsigned gen, unsigned G, unsigned b) {
    asm volatile("s_waitcnt vmcnt(0) lgkmcnt(0)" ::: "memory");
    __syncthreads();
    if (threadIdx.x == 0) {
        __builtin_amdgcn_fence(__ATOMIC_RELEASE, "agent");
        asm volatile("s_waitcnt vmcnt(0)" ::: "memory");
        const unsigned k = b & 7u, ngrp = G < 8u ? G : 8u, gsize = (G - k + 7u) / 8u;
        const unsigned old = __hip_atomic_fetch_add(bar + k * 64, 1u, __ATOMIC_RELAXED, __HIP_MEMORY_SCOPE_AGENT);
        if (old == gen * gsize - 1u) {
            const unsigned old2 = __hip_atomic_fetch_add(bar + 8 * 64, 1u, __ATOMIC_RELAXED, __HIP_MEMORY_SCOPE_AGENT);
            if (old2 == gen * ngrp - 1u) __hip_atomic_store(bar + 9 * 64, gen, __ATOMIC_RELAXED, __HIP_MEMORY_SCOPE_AGENT);
        }
        while (__hip_atomic_load(bar + 9 * 64, __ATOMIC_RELAXED, __HIP_MEMORY_SCOPE_AGENT) < gen) __builtin_amdgcn_s_sleep(1);
        __builtin_amdgcn_fence(__ATOMIC_ACQUIRE, "agent");
        asm volatile("s_waitcnt vmcnt(0)" ::: "memory");
    }
    __syncthreads();
}

#define XB_TMO      128
#define XB_XCNT(j)  (256  + 64 * (j))
#define XB_XSUB(j)  (1280 + 64 * (j))
#define XB_XGEN(j)  (2304 + 64 * (j))
#define XB_TOP      3328
#define XB_TOPGEN   3392
#define XCD_BAR_WORDS 3456
#define XB_SPIN_CAP (1u << 18)
constexpr size_t M_XBAR = WS_MISC + 900 * 1024;
constexpr int XB_ST_OFF = 143872;
__device__ __forceinline__ unsigned xb_ld(unsigned* p)              { return __hip_atomic_load(p, __ATOMIC_RELAXED, __HIP_MEMORY_SCOPE_AGENT); }
__device__ __forceinline__ unsigned xb_add(unsigned* p, unsigned v) { return __hip_atomic_fetch_add(p, v, __ATOMIC_RELAXED, __HIP_MEMORY_SCOPE_AGENT); }
__device__ __forceinline__ unsigned xb_xcc_id() { return (unsigned)__builtin_amdgcn_s_getreg((3 << 11) | 20) & 0xFu; }
#define XB_SPIN(cond, bar) do { unsigned _sp = 0; while (cond) { __builtin_amdgcn_s_sleep(1); \
    if ((++_sp & 255u) == 0u) { if (xb_ld(&(bar)[XB_TMO])) break; if (_sp > XB_SPIN_CAP) { atomicAdd(&(bar)[XB_TMO], 1u); break; } } } } while (0)
__device__ __forceinline__ void xcd_barrier_complete(unsigned* bar, unsigned x, unsigned& nloc, unsigned& nx, unsigned G) {
    unsigned sum, cnt, mine, sp = 0u;
    for (;;) {
        sum = 0u; cnt = 0u; mine = 0u;
#pragma unroll
        for (unsigned j = 0; j < 16; ++j) { const unsigned c = xb_ld(&bar[XB_XCNT(j)]); sum += c; cnt += (c > 0u) ? 1u : 0u; mine = (j == x) ? c : mine; }
        if (sum == G) break;
        __builtin_amdgcn_s_sleep(1);
        if ((++sp & 255u) == 0u) { if (xb_ld(&bar[XB_TMO])) break; if (sp > XB_SPIN_CAP) { atomicAdd(&bar[XB_TMO], 1u); break; } }
    }
    nloc = mine > 0u ? mine : 1u; nx = cnt > 0u ? cnt : 1u;
}
__device__ __forceinline__ void xcd_barrier(unsigned* bar, volatile LAS unsigned* st, unsigned G) {
    asm volatile("s_waitcnt vmcnt(0) lgkmcnt(0)" ::: "memory");
    __syncthreads();
    if (threadIdx.x == 0) {
        const unsigned x = xb_xcc_id();
        unsigned nloc = st[0], nx = st[1];
        if (nloc == 0u) { xcd_barrier_complete(bar, x, nloc, nx, G); st[0] = nloc; st[1] = nx; }
        const unsigned old = xb_add(&bar[XB_XSUB(x)], 1u);
        const unsigned gen = old / nloc;
        if (old + 1u == (gen + 1u) * nloc) {
            __builtin_amdgcn_fence(__ATOMIC_RELEASE, "agent");
            asm volatile("s_waitcnt vmcnt(0)" ::: "memory");
            const unsigned og = xb_add(&bar[XB_TOP], 1u);
            const unsigned tg = og / nx;
            if (og + 1u == (tg + 1u) * nx) xb_add(&bar[XB_TOPGEN], 1u);
            else XB_SPIN(xb_ld(&bar[XB_TOPGEN]) == tg, bar);
            __builtin_amdgcn_fence(__ATOMIC_ACQUIRE, "agent");
            xb_add(&bar[XB_XGEN(x)], 1u);
            asm volatile("s_waitcnt vmcnt(0)" ::: "memory");
        } else {
            XB_SPIN(xb_ld(&bar[XB_XGEN(x)]) == gen, bar);
            __builtin_amdgcn_fence(__ATOMIC_ACQUIRE, "agent");
            asm volatile("s_waitcnt vmcnt(0)" ::: "memory");
        }
    }
    __syncthreads();
}

__device__ __forceinline__ void transpose_item(const float* W, int K, int N, bf16_t* Wt, int item, LAS float* t, bool upperm = false) {
    const int tid = otid(); const int nbn = N >> 8; const int bn = item % nbn, tk = item / nbn;
    const float* src = W + (size_t)(tk * 64) * N + bn * 256;
    f32x4 v[8];
#pragma unroll
    for (int i = 0; i < 8; ++i) v[i] = *(const f32x4*)(src + (size_t)((tid >> 6) + 8 * i) * N + (tid & 63) * 4);
#pragma unroll
    for (int i = 0; i < 8; ++i) { LAS float* d = t + ((tid >> 6) + 8 * i) * 257 + (tid & 63) * 4; d[0] = v[i][0]; d[1] = v[i][1]; d[2] = v[i][2]; d[3] = v[i][3]; }
    __syncthreads();
#pragma unroll
    for (int j = 0; j < 4; ++j) { const int piece = tid + 512 * j; const int n = piece >> 3, ks = (piece & 7) * 8; float x[8];
#pragma unroll
        for (int q = 0; q < 8; ++q) x[q] = t[(ks + q) * 257 + n];
        u32x4 w; w.x = cvt_pk_bf16(x[0], x[1]); w.y = cvt_pk_bf16(x[2], x[3]); w.z = cvt_pk_bf16(x[4], x[5]); w.w = cvt_pk_bf16(x[6], x[7]);
        int c0 = bn * 256 + (n & ~63); if (upperm) { c0 = c0 < 2816 ? 256 * (c0 >> 7) + (c0 & 127) : 256 * ((c0 - 2816) >> 7) + 128 + ((c0 - 2816) & 127); }
        *(u32x4*)(Wt + (size_t)(c0 + (n & 63)) * K + tk * 64 + ks) = w; }
    __syncthreads();
}
__device__ __forceinline__ void convert_item(const Ctx& p, int layer, int it, LAS float* t) {
    unsigned char* ws = p.ws();
    if (layer == 0) {
        if (it < 128) { transpose_item(p.in(11), 1024, 2048, (bf16_t*)(ws + W_INAB), it, t); return; } it -= 128;
        if (it < 16) { transpose_item(p.in(19), 512, 512, (bf16_t*)(ws + W_GLU), it, t); return; } it -= 16;
        if (it < 64) { transpose_item(p.in(12), 1024, 1024, (bf16_t*)(ws + W_OUT), it, t); return; } it -= 64;
    } else {
        if (it < 160) { transpose_item(p.in(23), 1024, 2560, (bf16_t*)(ws + W_INCD), it, t); return; } it -= 160;
        if (it < 64) { transpose_item(p.in(24), 1024, 1024, (bf16_t*)(ws + W_OUT), it, t); return; } it -= 64;
    }
    if (it < 352) { transpose_item(p.in(33) + (size_t)layer * 1024 * 5632, 1024, 5632, (bf16_t*)(ws + W_UP), it, t, true); return; } it -= 352;
    transpose_item(p.in(36) + (size_t)layer * 2816 * 1024, 2816, 1024, (bf16_t*)(ws + W_DOWN), it, t);
}

__device__ __forceinline__ void mod_item(const Ctx& p, int it, LAS float* sil) {
    const int tid = otid(); const int l = it / 96, cg0 = (it % 96) * 64;
    LAS float* part = sil + 5 * 1024;
    for (int i = tid; i < 5 * 1024; i += 512) { const int c = i >> 10, k = i & 1023; const float v = c == 0 ? p.in(7)[k] : p.in(6)[(c - 1) * 1024 + k]; sil[i] = v / (1.0f + __expf(-v)); }
    __syncthreads();
    const int ks = tid >> 4, c4 = (tid & 15) * 4;
    const float* w = p.in(8) + (size_t)l * 1024 * 6144 + (size_t)(ks * 32) * 6144 + cg0 + c4;
    f32x4 a0 = {0.f, 0.f, 0.f, 0.f}, a1 = a0, a2 = a0, a3 = a0, a4 = a0;
#pragma unroll
    for (int hb = 0; hb < 2; ++hb) { f32x4 wv[16];
#pragma unroll
        for (int k = 0; k < 16; ++k) wv[k] = *(const f32x4*)(w + (size_t)(hb * 16 + k) * 6144);
#pragma unroll
        for (int k = 0; k < 16; ++k) { const int kk = ks * 32 + hb * 16 + k;
            a0 += sil[kk] * wv[k]; a1 += sil[1024 + kk] * wv[k]; a2 += sil[2048 + kk] * wv[k]; a3 += sil[3072 + kk] * wv[k]; a4 += sil[4096 + kk] * wv[k]; } }
#pragma unroll
    for (int j = 0; j < 4; ++j) { part[(ks * 5 + 0) * 64 + c4 + j] = a0[j]; part[(ks * 5 + 1) * 64 + c4 + j] = a1[j]; part[(ks * 5 + 2) * 64 + c4 + j] = a2[j]; part[(ks * 5 + 3) * 64 + c4 + j] = a3[j]; part[(ks * 5 + 4) * 64 + c4 + j] = a4[j]; }
    __syncthreads();
    if (tid < 320) { const int c = tid >> 6, cc = tid & 63; float s = p.in(9)[l * 6144 + cg0 + cc];
        for (int k2 = 0; k2 < 32; ++k2) s += part[(k2 * 5 + c) * 64 + cc];
        ((float*)(p.ws() + M_MOD))[(size_t)(l * 5 + c) * 6144 + cg0 + cc] = s; }
    __syncthreads();
}

__device__ __forceinline__ void s5_build(const Ctx& p, int g, int part, LAS unsigned char* lds) {
    const int tid = otid();
    LAS f32x2* apw = (LAS f32x2*)lds;
    LAS f32x2* Bt = apw + 2 * 64 * 17;
    LAS f32x2* Cc = Bt + 2 * 64 * 16;
    LAS float* Kt = (LAS float*)(Cc + 2 * 16 * 64);
    LAS f32x2* ft = (LAS f32x2*)(Kt + 2 * 16 * 256);
    const float *lam_re = p.in(13), *lam_im = p.in(14), *log_dt = p.in(15), *s5b = p.in(16), *s5c = p.in(17), *s5d = p.in(18);
    if (tid < 128) { const int d = tid >> 6, n = tid & 63; const float dt = expf(log_dt[d * 32 + g]); const float lr = lam_re[(d * 32 + g) * 64 + n], li = lam_im[(d * 32 + g) * 64 + n];
        const float mag = expf(lr * dt); float s, c; sincosf(li * dt, &s, &c); const float ar = mag * c, ai = mag * s;
        float pr = 1.f, pi = 0.f;
        for (int tau = 0; tau <= 16; ++tau) { apw[(d * 64 + n) * 17 + tau] = (f32x2){pr, pi}; const float nr2 = pr * ar - pi * ai, ni2 = pr * ai + pi * ar; pr = nr2; pi = ni2; }
        const float nr = ar - 1.0f, ni = ai, den = lr * lr + li * li;
        ft[d * 64 + n] = (f32x2){(nr * lr + ni * li) / den, (ni * lr - nr * li) / den}; }
    __syncthreads();
    for (int idx = tid; idx < 2048; idx += 512) { const int d = idx >> 10, n = (idx >> 4) & 63, q = idx & 15;
        const float br = s5b[(((size_t)(d * 2 + 0) * 32 + g) * 64 + n) * 16 + q], bi = s5b[(((size_t)(d * 2 + 1) * 32 + g) * 64 + n) * 16 + q]; const f32x2 f = ft[d * 64 + n];
        Bt[idx] = (f32x2){f.x * br - f.y * bi, f.x * bi + f.y * br};
        const int pp = (idx >> 6) & 15, n2 = idx & 63;
        Cc[idx] = (f32x2){s5c[(((size_t)(d * 2 + 0) * 32 + g) * 16 + pp) * 64 + n2], s5c[(((size_t)(d * 2 + 1) * 32 + g) * 16 + pp) * 64 + n2]}; }
    __syncthreads();
    if (part < 2) {
        const int d = tid >> 8, pp = (tid >> 4) & 15, q = tid & 15; float kacc[16];
#pragma unroll
        for (int tau = 0; tau < 16; ++tau) kacc[tau] = 0.f;
        for (int n = 0; n < 64; ++n) { const f32x2 c = Cc[(d * 16 + pp) * 64 + n], b = Bt[(d * 64 + n) * 16 + q], a = apw[(d * 64 + n) * 17 + 1];
            float xr = c.x * b.x - c.y * b.y, xi = c.x * b.y + c.y * b.x;
#pragma unroll
            for (int tau = 0; tau < 16; ++tau) { kacc[tau] += xr; const float nr2 = xr * a.x - xi * a.y, ni2 = xr * a.y + xi * a.x; xr = nr2; xi = ni2; } }
#pragma unroll
        for (int tau = 0; tau < 16; ++tau) Kt[(d * 16 + tau) * 256 + pp * 16 + q] = kacc[tau];
    }
    __syncthreads();
    bf16_t* H = (bf16_t*)(p.ws() + A_HCAT) + (size_t)g * 65536;
    if (part == 2) for (int idx = tid; idx < 65536; idx += 512) { const int row = idx >> 8, col = idx & 255, d = row >> 7, c = (row >> 6) & 1, n = row & 63, s = col >> 4, q = col & 15;
        const f32x2 a = apw[(d * 64 + n) * 17 + (d == 0 ? 15 - s : s)], b = Bt[(d * 64 + n) * 16 + q];
        H[idx] = f2bf(c == 0 ? a.x * b.x - a.y * b.y : a.x * b.y + a.y * b.x); }
    bf16_t* Wb = (bf16_t*)(p.ws() + A_WB) + (size_t)g * 131072;
    if (part != 2) for (int i2 = tid; i2 < 32768; i2 += 512) {
      {
        const int idx = part == 3 ? ((i2 >> 7) << 9) + 256 + ((i2 & 127) << 1) : (((i2 >> 8) + 128 * part) << 9) + (i2 & 255);
       for (int sub = 0; sub < (part == 3 ? 2 : 1); ++sub) {
        const int idx2 = idx + sub;
        const int row = idx2 >> 9, col = idx2 & 511, t = row >> 4, pp = row & 15; float v;
        if (col < 256) { const int s = col >> 4, q = col & 15; v = 0.f;
            if (s <= t) v += Kt[(t - s) * 256 + pp * 16 + q];
            if (s >= t) v += Kt[(16 + s - t) * 256 + pp * 16 + q];
            if (s == t && pp == q) v += s5d[16 * g + pp]; }
        else { const int cc = col - 256, d = cc >> 7, c = (cc >> 6) & 1, n = cc & 63; const f32x2 cv = Cc[(d * 16 + pp) * 64 + n], a = apw[(d * 64 + n) * 17 + (d == 0 ? t + 1 : 16 - t)];
            const float zr = cv.x * a.x - cv.y * a.y, zi = cv.x * a.y + cv.y * a.x; v = c == 0 ? zr : -zi; }
        Wb[idx2] = f2bf(v); } } }
    __syncthreads();
}

__device__ __forceinline__ void phase_prep(const Ctx& p, LAS unsigned char* lds, int stage) {
    const int bid = blockIdx.x, nb = gridDim.x, tid = otid();
    if (stage == 0) { for (int it = bid; it < 192; it += nb) mod_item(p, it, (LAS float*)lds); return; }
    for (int it = bid; it < 128 + 736; it += nb) {
        if (it < 128) s5_build(p, it >> 2, it & 3, lds);
        else convert_item(p, 0, it - 128, (LAS float*)lds);
    }
    const size_t gt = (size_t)bid * 512 + tid, gs = (size_t)nb * 512;
    { bf16_t* KS = (bf16_t*)(p.ws() + A_KS); const float* ck = p.in(2);
      for (size_t i = gt; i < 4 * 512 * 64; i += gs) { const int c8 = (int)(i & 63) * 8; const int kk = (int)(i >> 6) & 511; const int sb = (int)(i >> 15);
          const float* s = ck + ((size_t)(sb * 512 + kk)) * 512 + c8; const f32x4 a = *(const f32x4*)s, b = *(const f32x4*)(s + 4);
          u32x4 w; w.x = cvt_pk_bf16(a[0], a[1]); w.y = cvt_pk_bf16(a[2], a[3]); w.z = cvt_pk_bf16(b[0], b[1]); w.w = cvt_pk_bf16(b[2], b[3]);
          *(u32x4*)(KS + ((size_t)(sb * 2560 + 2048 + kk)) * 512 + c8) = w; } }
    { bf16_t* VTS = (bf16_t*)(p.ws() + A_VTS); const float* cvv = p.in(3);
      for (size_t i = gt; i < 4 * 64 * 512; i += gs) { const int col = (int)(i & 511); const int k8 = (int)(i >> 9) & 63; const int sb = (int)(i >> 15);
          const float* s = cvv + ((size_t)(sb * 512 + k8 * 8)) * 512 + col; float v[8];
#pragma unroll
          for (int q = 0; q < 8; ++q) v[q] = s[(size_t)q * 512];
          u32x4 w; w.x = cvt_pk_bf16(v[0], v[1]); w.y = cvt_pk_bf16(v[2], v[3]); w.z = cvt_pk_bf16(v[4], v[5]); w.w = cvt_pk_bf16(v[6], v[7]);
          *(u32x4*)(VTS + ((size_t)(sb * 512 + col)) * 2560 + 2048 + k8 * 8) = w; } }
    { f32x2* rope = (f32x2*)(p.ws() + M_ROPE);
      for (size_t i = gt; i < 2048 * 32; i += gs) { const int f = (int)(i & 15), a = (int)(i >> 4) & 1, t = (int)(i >> 5); const float pos = (float)(a == 0 ? (t >> 6) : (t & 63));
          const float inv = exp2f(-(float)f * (13.287712379549449f / 16.0f)); float s, c; sincosf(pos * inv, &s, &c); rope[i] = (f32x2){c, s}; } }
    { float* sp8 = (float*)(p.ws() + M_SP8); for (size_t i = gt; i < 1024; i += gs) { const float lam = p.in(32)[i]; sp8[i] = 8.0f * log1pf(expf(-lam)); } }
    if (bid == 0 && tid < 64) { const float* dl = p.in(21); const float s01 = wave_sum(dl[tid] * dl[64 + tid]), s23 = wave_sum(dl[128 + tid] * dl[192 + tid]);
        if (tid == 0) ((float*)(p.ws() + M_SCAL))[0] = expf(s01) - expf(s23) + 0.2f; }
}

__device__ __forceinline__ void phase_convert_l1(const Ctx& p, LAS unsigned char* lds, int it_lo = 0, int it_hi = 752, bool gate = true) {
    const int bid = blockIdx.x, nb = gridDim.x, tid = otid();
    for (int it = it_lo + bid; it < it_hi; it += nb) convert_item(p, 1, it, (LAS float*)lds);
    if (!gate) return;
    bf16_t* Wg = (bf16_t*)(p.ws() + W_GATE);
    for (size_t i = (size_t)bid * 512 + tid; i < 2048 * 64; i += (size_t)nb * 512) { const int k0 = (int)(i & 63) * 8; const int cp = (int)(i >> 6);
        const int dir = cp >> 10, rest = cp & 1023, blk32 = rest >> 5, gate = (rest >> 4) & 1, ch = blk32 * 16 + (rest & 15), blk = ch >> 6, dout = ch & 63;
        u32x4 w = (u32x4){0u, 0u, 0u, 0u};
        if ((k0 >> 6) == blk) { const float* src = (gate ? p.in(30) : p.in(28)) + (((size_t)(dir * 8 + blk) * 64 + (k0 & 63)) * 64 + dout);
            w.x = cvt_pk_bf16(src[0], src[64]); w.y = cvt_pk_bf16(src[128], src[192]); w.z = cvt_pk_bf16(src[256], src[320]); w.w = cvt_pk_bf16(src[384], src[448]); }
        *(u32x4*)(Wg + (size_t)cp * 512 + k0) = w; }
}

template <bool POST, bool PRE, bool XIN>
__device__ __forceinline__ void post_pre(const Ctx& p, int lpost, int jpost, int lpre, int jpre) {
    const int lane = otid() & 63, gw = blockIdx.x * 8 + (otid() >> 6), nw = gridDim.x * 8;
    const float* MOD = (const float*)(p.ws() + M_MOD); const float* ng = p.in(10);
    float* X = p.out(); const bf16_t* Y = (const bf16_t*)(p.ws() + A_Y); bf16_t* H = (bf16_t*)(p.ws() + WS_H);
    for (int row = gw; row < NTOK; row += nw) {
        const int cv = row < NPROMPT ? 0 : 1 + ((row - NPROMPT) >> 11);
        const float* xr = XIN ? (row < NPROMPT ? p.in(0) + (size_t)row * DM : p.in(1) + (size_t)(row - NPROMPT) * DM) : X + (size_t)row * DM;
        f32x4 x[4];
#pragma unroll
        for (int i = 0; i < 4; ++i) x[i] = *(const f32x4*)(xr + 4 * lane + 256 * i);
        if (POST) {
            f32x4 y[4]; float ss = 0.f;
#pragma unroll
            for (int i = 0; i < 4; ++i) { const u32x2 yw = *(const u32x2*)(Y + (size_t)row * DM + 4 * lane + 256 * i); y[i] = (f32x4){bflo(yw.x), bfhi(yw.x), bflo(yw.y), bfhi(yw.y)};
                ss += y[i][0] * y[i][0] + y[i][1] * y[i][1] + y[i][2] * y[i][2] + y[i][3] * y[i][3]; }
            ss = wave_sum(ss); const float r = rsqrtf(ss * (1.0f / 1024.0f) + 1e-6f);
            const float* gp = ng + (lpost * 4 + (jpost ? 3 : 1)) * 1024; const float* gate = MOD + ((size_t)(lpost * 5 + cv) * 6 + 3 * jpost + 2) * 1024;
#pragma unroll
            for (int i = 0; i < 4; ++i) { const f32x4 g4 = *(const f32x4*)(gp + 4 * lane + 256 * i), t4 = *(const f32x4*)(gate + 4 * lane + 256 * i);
                x[i] = x[i] + t4 * (y[i] * r * g4); *(f32x4*)(X + (size_t)row * DM + 4 * lane + 256 * i) = x[i]; }
        }
        if (PRE) {
            float ss = 0.f;
#pragma unroll
            for (int i = 0; i < 4; ++i) ss += x[i][0] * x[i][0] + x[i][1] * x[i][1] + x[i][2] * x[i][2] + x[i][3] * x[i][3];
            ss = wave_sum(ss); const float r = rsqrtf(ss * (1.0f / 1024.0f) + 1e-6f);
            const float* gq = ng + (lpre * 4 + (jpre ? 2 : 0)) * 1024; const float* sh = MOD + ((size_t)(lpre * 5 + cv) * 6 + 3 * jpre) * 1024; const float* sc = sh + 1024;
#pragma unroll
            for (int i = 0; i < 4; ++i) { const f32x4 g4 = *(const f32x4*)(gq + 4 * lane + 256 * i), s4 = *(const f32x4*)(sh + 4 * lane + 256 * i), c4 = *(const f32x4*)(sc + 4 * lane + 256 * i);
                const f32x4 h = x[i] * r * g4 * (1.0f + c4) + s4; u32x2 w; w.x = cvt_pk_bf16(h[0], h[1]); w.y = cvt_pk_bf16(h[2], h[3]);
                *(u32x2*)(H + (size_t)row * DM + 4 * lane + 256 * i) = w;
                if (XIN && !POST) { u32x2 xb; xb.x = cvt_pk_bf16(x[i][0], x[i][1]); xb.y = cvt_pk_bf16(x[i][2], x[i][3]);
                    *(u32x2*)((bf16_t*)X + (size_t)row * DM + 4 * lane + 256 * i) = xb; } }
        }
    }
}

__device__ __forceinline__ void attn_item(const Ctx& p, LAS unsigned char* lds, bool samp, int b, int h, int qb) {
    int tid_ = otid();
    const int tid = tid_, wid = tid >> 6, lane = tid & 63, fr = lane & 15, fq = lane >> 4;
    const int Lk = samp ? 2560 : 256;
    const int row0 = samp ? NPROMPT + b * 2048 + qb * 128 : b * 256 + qb * 128;
    const bf16_t* Kb = samp ? (const bf16_t*)(p.ws() + A_KS) + (size_t)b * 2560 * 512 : (const bf16_t*)(p.ws() + A_KP) + (size_t)b * 256 * 512;
    const bf16_t* Vt = (samp ? (const bf16_t*)(p.ws() + A_VTS) : (const bf16_t*)(p.ws() + A_VTP)) + (size_t)(b * 4 + h) * 128 * Lk;
    const bf16_t* Qp = (const bf16_t*)(p.ws() + A_Q) + (size_t)(row0 + wid * 16 + fr) * 512 + h * 128;
    bf16x8 Qf[2][2];
#pragma unroll
    for (int m = 0; m < 2; ++m)
#pragma unroll
        for (int ks = 0; ks < 2; ++ks) Qf[m][ks] = *(const bf16x8*)(Qp + m * 64 + ks * 32 + fq * 8);
    f32x4 O[2][8];
#pragma unroll
    for (int m = 0; m < 2; ++m)
#pragma unroll
        for (int k = 0; k < 8; ++k) O[m][k] = (f32x4){0.f, 0.f, 0.f, 0.f};
    float mrun[2] = {-INFINITY, -INFINITY}, lrun[2] = {0.f, 0.f};
    const float csc = 0.125f * 1.4426950408889634f;
    const int kkey = tid >> 3, kpart = tid & 7, vdv = tid >> 2, vpart = tid & 3;
    const bf16_t* ksrc = Kb + (size_t)kkey * 512 + h * 128 + kpart * 16;
    const bf16_t* vsrc = Vt + (size_t)vdv * Lk + vpart * 16;
    const int kdst = ((kpart >> 2) * 64 + kkey) * 144 + (kpart & 3) * 32, vdst = 2 * 64 * 144 + vdv * 144 + vpart * 32;
    const int ntile = Lk / 64;
    u32x4 kr0 = *(const u32x4*)ksrc, kr1 = *(const u32x4*)(ksrc + 8), vr0 = *(const u32x4*)vsrc, vr1 = *(const u32x4*)(vsrc + 8);
    __syncthreads();
#define ATT_STORE(LB) do { *(LAS u32x4*)((LB) + kdst) = kr0; *(LAS u32x4*)((LB) + kdst + 16) = kr1; *(LAS u32x4*)((LB) + vdst) = vr0; *(LAS u32x4*)((LB) + vdst + 16) = vr1; } while (0)
#define ATT_FETCH(T) do { const bf16_t* ks2 = ksrc + (size_t)(T) * 64 * 512; const bf16_t* vs2 = vsrc + (T) * 64; \
        kr0 = *(const u32x4*)ks2; kr1 = *(const u32x4*)(ks2 + 8); vr0 = *(const u32x4*)vs2; vr1 = *(const u32x4*)(vs2 + 8); } while (0)
#define ATT_QK(S, LB) do { _Pragma("unroll") for (int m = 0; m < 2; ++m) { _Pragma("unroll") for (int kb = 0; kb < 4; ++kb) { S[m][kb] = (f32x4){0.f, 0.f, 0.f, 0.f}; \
        _Pragma("unroll") for (int ks = 0; ks < 2; ++ks) { const bf16x8 A_ = *(const LAS bf16x8*)((LB) + (m * 64 + kb * 16 + fr) * 144 + (ks * 32 + fq * 8) * 2); \
            S[m][kb] = __builtin_amdgcn_mfma_f32_16x16x32_bf16(A_, Qf[m][ks], S[m][kb], 0, 0, 0); } } __builtin_amdgcn_sched_barrier(0); } } while (0)
    f32x4 s[2][4];
    ATT_STORE(lds);
    __syncthreads();
    if (ntile > 1) ATT_FETCH(1);
    ATT_QK(s, lds);
    int bcur = 0, bnxt = 1;
    for (int kt = 0; kt < ntile; ++kt) {
        LAS unsigned char* ldsV = lds + bcur * 36864 + 2 * 64 * 144;
        const bool more = kt + 1 < ntile;
        f32x4 sn[2][4];
        if (more) { LAS unsigned char* lb1 = lds + bnxt * 36864;
            ATT_STORE(lb1);
            __syncthreads();
            if (kt + 2 < ntile) ATT_FETCH(kt + 2);
            ATT_QK(sn, lb1); }
        float tmax[2];
#pragma unroll
        for (int m = 0; m < 2; ++m) { float t = s[m][0][0];
#pragma unroll
            for (int kb = 0; kb < 4; ++kb)
#pragma unroll
                for (int j = 0; j < 4; ++j) t = fmaxf(t, s[m][kb][j]);
            tmax[m] = t; }
        tmax[0] = fmaxf(tmax[0], __shfl_xor(tmax[0], 16)); tmax[1] = fmaxf(tmax[1], __shfl_xor(tmax[1], 16));
        tmax[0] = fmaxf(tmax[0], __shfl_xor(tmax[0], 32)); tmax[1] = fmaxf(tmax[1], __shfl_xor(tmax[1], 32));
#pragma unroll
        for (int m = 0; m < 2; ++m) {
            const float mnew = fmaxf(mrun[m], tmax[m]); const float alpha = __builtin_amdgcn_exp2f((mrun[m] - mnew) * csc); mrun[m] = mnew;
            const float mc = mnew * csc;
            float psum = 0.f;
#pragma unroll
            for (int kb = 0; kb < 4; ++kb)
#pragma unroll
                for (int j = 0; j < 4; ++j) { s[m][kb][j] = __builtin_amdgcn_exp2f(s[m][kb][j] * csc - mc); psum += s[m][kb][j]; }
            lrun[m] = lrun[m] * alpha + psum;
#pragma unroll
            for (int k = 0; k < 8; ++k) O[m][k] *= alpha;
        }
#pragma unroll
        for (int kg = 0; kg < 2; ++kg) {
            bf16x8 B[2];
#pragma unroll
            for (int m = 0; m < 2; ++m) { u32x4 pw; pw.x = cvt_pk_bf16(s[m][2 * kg][0], s[m][2 * kg][1]); pw.y = cvt_pk_bf16(s[m][2 * kg][2], s[m][2 * kg][3]);
                pw.z = cvt_pk_bf16(s[m][2 * kg + 1][0], s[m][2 * kg + 1][1]); pw.w = cvt_pk_bf16(s[m][2 * kg + 1][2], s[m][2 * kg + 1][3]); B[m] = __builtin_bit_cast(bf16x8, pw); }
#pragma unroll
            for (int blk = 0; blk < 8; ++blk) { LAS unsigned char* vp = ldsV + (blk * 16 + fr) * 144 + (kg * 32 + 4 * fq) * 2;
                const u32x2 lo = *(const LAS u32x2*)vp, hi = *(const LAS u32x2*)(vp + 32);
                const bf16x8 A = __builtin_bit_cast(bf16x8, ((u32x4){lo.x, lo.y, hi.x, hi.y}));
                O[0][blk] = __builtin_amdgcn_mfma_f32_16x16x32_bf16(A, B[0], O[0][blk], 0, 0, 0);
                O[1][blk] = __builtin_amdgcn_mfma_f32_16x16x32_bf16(A, B[1], O[1][blk], 0, 0, 0); }
            __builtin_amdgcn_sched_barrier(0);
        }
        if (more) {
#pragma unroll
            for (int m = 0; m < 2; ++m)
#pragma unroll
                for (int kb = 0; kb < 4; ++kb) s[m][kb] = sn[m][kb]; }
        bcur = bnxt; bnxt = bnxt == 2 ? 0 : bnxt + 1;
    }
#undef ATT_STORE
#undef ATT_FETCH
#undef ATT_QK
    float l0 = lrun[0], l1 = lrun[1];
    l0 += __shfl_xor(l0, 16); l0 += __shfl_xor(l0, 32); l1 += __shfl_xor(l1, 16); l1 += __shfl_xor(l1, 32);
    const float lam = ((const float*)(p.ws() + M_SCAL))[0];
    const float i0 = 1.0f / l0, i1 = lam / l1;
    float ss = 0.f;
#pragma unroll
    for (int k = 0; k < 8; ++k)
#pragma unroll
        for (int j = 0; j < 4; ++j) { const float o = O[0][k][j] * i0 - O[1][k][j] * i1; O[0][k][j] = o; ss += o * o; }
    ss += __shfl_xor(ss, 16); ss += __shfl_xor(ss, 32);
    const float r = rsqrtf(ss * (1.0f / 128.0f) + 1e-6f) * 0.8f;
    bf16_t* outp = (bf16_t*)(p.ws() + WS_H) + (size_t)(row0 + wid * 16 + fr) * 1024 + 512 + h * 128;
    const float* dg = p.in(22);
#pragma unroll
    for (int k = 0; k < 8; ++k) { const f32x4 g4 = *(const f32x4*)(dg + k * 16 + 4 * fq); const f32x4 o = O[0][k] * r * g4;
        u32x2 w; w.x = cvt_pk_bf16(o[0], o[1]); w.y = cvt_pk_bf16(o[2], o[3]); *(u32x2*)(outp + k * 16 + 4 * fq) = w; }
}
__device__ __forceinline__ void phase_attn(const Ctx& p, LAS unsigned char* lds) {
    for (int it = blockIdx.x; it < 256; it += gridDim.x) {
        attn_item(p, lds, true, it >> 6, (it >> 4) & 3, it & 15);
        attn_item(p, lds, false, it >> 3, (it >> 1) & 3, it & 1);
    }
}

__device__ __forceinline__ void s5_rec_one(const Ctx& p, const float* E, bf16_t* AB, int n, int d, int g, int sq) {
    const float *lam_re = p.in(13), *lam_im = p.in(14), *log_dt = p.in(15);
    const bool samp = sq < 4; const int j0 = samp ? 512 + 128 * sq : 16 * (sq - 4), nj = samp ? 128 : 16;
    const float dt = expf(log_dt[d * 32 + g]); const float lr = lam_re[(d * 32 + g) * 64 + n], li = lam_im[(d * 32 + g) * 64 + n];
    const float mag = expf(16.0f * lr * dt); float sn, cs; sincosf(16.0f * li * dt, &sn, &cs); const float ar = mag * cs, ai = mag * sn;
    float sr = 0.f, si = 0.f;
    if (samp) { sr = p.in(4)[((size_t)((sq * 2 + d) * 2 + 0) * 32 + g) * 64 + n]; si = p.in(4)[((size_t)((sq * 2 + d) * 2 + 1) * 32 + g) * 64 + n]; }
    const int eo = d * 128 + n, so = 256 + d * 128 + n;
    for (int jj = 0; jj < nj; jj += 16) {
        float er[16], ei[16];
#pragma unroll
        for (int u = 0; u < 16; ++u) { const int j = d == 0 ? j0 + jj + u : j0 + nj - 1 - jj - u; const float* ep = E + ((size_t)(g * 1024 + j)) * 256 + eo; er[u] = ep[0]; ei[u] = ep[64]; }
#pragma unroll
        for (int u = 0; u < 16; ++u) { const int j = d == 0 ? j0 + jj + u : j0 + nj - 1 - jj - u; bf16_t* sp = AB + ((size_t)(g * 1024 + j)) * 512 + so;
            sp[0] = f2bf(sr); sp[64] = f2bf(si);
            const float nr = ar * sr - ai * si + er[u], ni = ar * si + ai * sr + ei[u]; sr = nr; si = ni; }
    }
    if (!samp) { float* o = p.out() + O_S5 + ((size_t)(((sq - 4) * 2 + d) * 2) * 32 + g) * 64 + n; o[0] = sr; o[2048] = si; }
}
__device__ __forceinline__ void phase_s5_rec(const Ctx& p, int bid, int nblk) {
    const float* E = (const float*)(p.ws() + A_E); bf16_t* AB = (bf16_t*)(p.ws() + A_AB);
    for (int idx = bid * 512 + otid(); idx < 36 * 4096; idx += nblk * 512) s5_rec_one(p, E, AB, idx & 63, (idx >> 6) & 1, (idx >> 7) & 31, idx >> 12);
}
__device__ __forceinline__ void s5_rec_unit(const Ctx& p, int L) {
    const float* E = (const float*)(p.ws() + A_E); bf16_t* AB = (bf16_t*)(p.ws() + A_AB);
    const int g = L >> 2, i = L & 3, nitems = i < 2 ? 2048 : 256;
    for (int idx = otid(); idx < nitems; idx += 512) { const int sl = idx >> 7; s5_rec_one(p, E, AB, idx & 63, (idx >> 6) & 1, g, i < 2 ? 4 + 16 * i + sl : 2 * (i - 2) + sl); }
}

__device__ __forceinline__ void phase_ffn_conv(const Ctx& p, int layer, int hf) {
    const bf16_t* U = (const bf16_t*)(p.ws() + A_U); bf16_t* A2 = (bf16_t*)(p.ws() + A_A2) + (size_t)hf * 8192 * 2816;
    const float* cw = p.in(34) + (size_t)layer * 3 * 5632; const float* cb = p.in(35) + (size_t)layer * 5632;
    const int Lm = hf ? 2047 : 255;
    for (size_t idx = (size_t)blockIdx.x * 512 + otid(); idx < (size_t)8192 * 352; idx += (size_t)gridDim.x * 512) {
        const int cc = (int)(idx % 352) * 8; const int rl = (int)(idx / 352); const int pos = rl & Lm;
        float g[8], v[8];
#pragma unroll
        for (int e = 0; e < 8; ++e) { g[e] = cb[cc + e]; v[e] = cb[2816 + cc + e]; }
#pragma unroll
        for (int j = 0; j < 3; ++j) { const int dj = j - 1; if ((dj < 0 && pos == 0) || (dj > 0 && pos == Lm)) continue;
            const bf16_t* ur = U + (size_t)(rl + dj) * 5632 + cc; float a[8], b[8]; unpack8(*(const u32x4*)ur, a); unpack8(*(const u32x4*)(ur + 2816), b);
            const float* w = cw + j * 5632 + cc;
#pragma unroll
            for (int e = 0; e < 8; ++e) { g[e] += w[e] * a[e]; v[e] += w[2816 + e] * b[e]; } }
        float o[8];
#pragma unroll
        for (int e = 0; e < 8; ++e) o[e] = gelu_t(g[e]) * v[e];
        u32x4 w; w.x = cvt_pk_bf16(o[0], o[1]); w.y = cvt_pk_bf16(o[2], o[3]); w.z = cvt_pk_bf16(o[4], o[5]); w.w = cvt_pk_bf16(o[6], o[7]);
        *(u32x4*)(A2 + (size_t)rl * 2816 + cc) = w;
    }
}

__device__ __forceinline__ void phase_cd_conv(const Ctx& p) {
    const bf16_t *XIN = (const bf16_t*)(p.ws() + A_XIN), *BG = (const bf16_t*)(p.ws() + A_BG), *CG = (const bf16_t*)(p.ws() + A_CG), *XR = (const bf16_t*)(p.ws() + A_XR);
    bf16_t* CAT = (bf16_t*)(p.ws() + WS_H); bf16_t* XC = (bf16_t*)(p.ws() + A_XC);
    const float *scw = p.in(25), *cw = p.in(26), *cb = p.in(27);
    for (size_t idx = (size_t)blockIdx.x * 512 + otid(); idx < (size_t)NTOK * 64; idx += (size_t)gridDim.x * 512) {
        const int ch = (int)(idx & 63) * 8; const int row = (int)(idx >> 6);
        const int pos = row < NPROMPT ? (row & 255) : ((row - NPROMPT) & 2047); const int L = row < NPROMPT ? 256 : 2048;
        float yc[8], xc[8];
#pragma unroll
        for (int e = 0; e < 8; ++e) { yc[e] = 0.f; xc[e] = cb[ch + e]; }
#pragma unroll
        for (int j = 0; j < 3; ++j) { const int t = pos + j - 1; if (t < 0 || t >= L) continue;
            float a[8], b[8]; unpack8(*(const u32x4*)(CG + (size_t)(row + j - 1) * 512 + ch), a); unpack8(*(const u32x4*)(XIN + (size_t)(row + j - 1) * 512 + ch), b);
#pragma unroll
            for (int e = 0; e < 8; ++e) yc[e] += scw[j * 512 + ch + e] * (a[e] * b[e]); }
#pragma unroll
        for (int j = 0; j < 4; ++j) { const int t = pos + j - 2; if (t < 0 || t >= L) continue;
            float a[8]; unpack8(*(const u32x4*)(XR + (size_t)(row + j - 2) * 512 + ch), a);
#pragma unroll
            for (int e = 0; e < 8; ++e) xc[e] += cw[j * 512 + ch + e] * a[e]; }
        float bg[8]; unpack8(*(const u32x4*)(BG + (size_t)row * 512 + ch), bg);
#pragma unroll
        for (int e = 0; e < 8; ++e) yc[e] *= bg[e];
        u32x4 w; w.x = cvt_pk_bf16(yc[0], yc[1]); w.y = cvt_pk_bf16(yc[2], yc[3]); w.z = cvt_pk_bf16(yc[4], yc[5]); w.w = cvt_pk_bf16(yc[6], yc[7]);
        *(u32x4*)(CAT + (size_t)row * 1024 + ch) = w;
        w.x = cvt_pk_bf16(xc[0], xc[1]); w.y = cvt_pk_bf16(xc[2], xc[3]); w.z = cvt_pk_bf16(xc[4], xc[5]); w.w = cvt_pk_bf16(xc[6], xc[7]);
        *(u32x4*)(XC + (size_t)row * 512 + ch) = w;
    }
}

constexpr size_t M_SEG = WS_MISC + 1024 * 1024;
template <int D>
__device__ __forceinline__ void lru_load(const bf16_t* LA, const bf16_t* BV, int sg, int w, int ch, unsigned short (&la)[32], unsigned short (&bv)[32]) {
    const long row0 = D == 0 ? 256 * sg + 32 * w : 256 * sg + 255 - 32 * w;
    const bf16_t* pl = LA + ((size_t)D * NTOK + row0) * 512 + ch; const bf16_t* pb = BV + ((size_t)D * NTOK + row0) * 512 + ch;
#pragma unroll
    for (int i = 0; i < 32; ++i) { la[i] = pl[(D == 0 ? i : -i) * 512]; bv[i] = pb[(D == 0 ? i : -i) * 512]; }
}
__device__ __forceinline__ void lru_agg(const unsigned short (&la)[32], const unsigned short (&bv)[32], float& Pw, float& Ew) {
    Pw = 1.f; Ew = 0.f;
#pragma unroll
    for (int i = 0; i < 32; ++i) { const float a = __expf(bf2f(la[i])); Ew = a * Ew + bf2f(bv[i]); Pw *= a; }
}
__device__ __forceinline__ void phase_lru_a(const Ctx& p, LAS unsigned char* lds) {
    const int tid = otid(), w = tid >> 6, lane = tid & 63;
    LAS float* PE = (LAS float*)lds;
    const bf16_t *LA = (const bf16_t*)(p.ws() + A_LA), *BV = (const bf16_t*)(p.ws() + A_BV);
    float* SEG = (float*)(p.ws() + M_SEG);
    for (int it = blockIdx.x; it < 512; it += gridDim.x) {
        const int sg = it >> 3, ch = (it & 7) * 64 + lane;
        { unsigned short la[32], bv[32]; lru_load<0>(LA, BV, sg, w, ch, la, bv); float Pw, Ew; lru_agg(la, bv, Pw, Ew); PE[w * 64 + lane] = Pw; PE[1024 + w * 64 + lane] = Ew; }
        { unsigned short la[32], bv[32]; lru_load<1>(LA, BV, sg, w, ch, la, bv); float Pw, Ew; lru_agg(la, bv, Pw, Ew); PE[(8 + w) * 64 + lane] = Pw; PE[1024 + (8 + w) * 64 + lane] = Ew; }
        __syncthreads();
        if (w < 2) { float P = 1.f, E = 0.f;
#pragma unroll
            for (int w2 = 0; w2 < 8; ++w2) { const float P2 = PE[(w * 8 + w2) * 64 + lane], E2 = PE[1024 + (w * 8 + w2) * 64 + lane]; E = P2 * E + E2; P *= P2; }
            *(f32x2*)(SEG + ((size_t)(w * 64 + sg) * 512 + ch) * 2) = (f32x2){P, E}; }
        __syncthreads();
    }
}
__device__ __forceinline__ void phase_lru_b(const Ctx& p, LAS unsigned char* lds) {
    const int tid = otid(), w = tid >> 6, lane = tid & 63;
    LAS float* HFs = (LAS float*)lds;
    LAS float* PE = (LAS float*)(lds + 65536);
    const bf16_t *LA = (const bf16_t*)(p.ws() + A_LA), *BV = (const bf16_t*)(p.ws() + A_BV), *GB = (const bf16_t*)(p.ws() + A_GB);
    const float* SEG = (const float*)(p.ws() + M_SEG); bf16_t* CAT = (bf16_t*)(p.ws() + WS_H);
    for (int it = blockIdx.x; it < 512; it += gridDim.x) {
        const int sg = it >> 3, ch = (it & 7) * 64 + lane;
        const bool samp = sg >= 32; const int sb = (sg - 32) >> 3, sp = (sg - 32) & 7;
        { unsigned short la[32], bv[32]; lru_load<0>(LA, BV, sg, w, ch, la, bv);
          float c = samp ? p.in(5)[(size_t)(sb * 2 + 0) * 512 + ch] : 0.f;
          if (samp) {
#pragma unroll
              for (int s2 = 0; s2 < 7; ++s2) if (s2 < sp) { const f32x2 pe = *(const f32x2*)(SEG + ((size_t)(0 * 64 + 32 + 8 * sb + s2) * 512 + ch) * 2); c = pe.x * c + pe.y; } }
          float Pw, Ew; lru_agg(la, bv, Pw, Ew); PE[w * 64 + lane] = Pw; PE[512 + w * 64 + lane] = Ew;
          __syncthreads();
          float cseg = c;
#pragma unroll
          for (int w2 = 0; w2 < 8; ++w2) { const float P2 = PE[w2 * 64 + lane], E2 = PE[512 + w2 * 64 + lane]; cseg = P2 * cseg + E2; if (w2 < w) c = P2 * c + E2; }
          float h = c;
#pragma unroll
          for (int i = 0; i < 32; ++i) { h = __expf(bf2f(la[i])) * h + bf2f(bv[i]); HFs[(32 * w + i) * 64 + lane] = h; }
          if (!samp && w == 0) p.out()[O_LRU + (size_t)(sg * 2 + 0) * 512 + ch] = cseg;
          __syncthreads(); }
        { unsigned short la[32], bv[32], gb[32]; lru_load<1>(LA, BV, sg, w, ch, la, bv);
          const long row0 = 256 * sg + 255 - 32 * w;
          { const bf16_t* pg = GB + (size_t)row0 * 512 + ch;
#pragma unroll
            for (int i = 0; i < 32; ++i) gb[i] = pg[-i * 512]; }
          float c = samp ? p.in(5)[(size_t)(sb * 2 + 1) * 512 + ch] : 0.f;
          if (samp) {
#pragma unroll
              for (int s2 = 7; s2 > 0; --s2) if (s2 > sp) { const f32x2 pe = *(const f32x2*)(SEG + ((size_t)(1 * 64 + 32 + 8 * sb + s2) * 512 + ch) * 2); c = pe.x * c + pe.y; } }
          float Pw, Ew; lru_agg(la, bv, Pw, Ew); PE[w * 64 + lane] = Pw; PE[512 + w * 64 + lane] = Ew;
          __syncthreads();
          float cseg = c;
#pragma unroll
          for (int w2 = 0; w2 < 8; ++w2) { const float P2 = PE[w2 * 64 + lane], E2 = PE[512 + w2 * 64 + lane]; cseg = P2 * cseg + E2; if (w2 < w) c = P2 * c + E2; }
          float h = c; bf16_t* pc = CAT + (size_t)row0 * 1024 + 512 + ch;
#pragma unroll
          for (int i = 0; i < 32; ++i) { h = __expf(bf2f(la[i])) * h + bf2f(bv[i]); const float hs = HFs[(255 - 32 * w - i) * 64 + lane] + h;
              pc[-i * 1024] = f2bf(hs * gelu_t(bf2f(gb[i]))); }
          if (!samp && w == 0) p.out()[O_LRU + (size_t)(sg * 2 + 1) * 512 + ch] = cseg;
          __syncthreads(); }
    }
}

#define REPG 1
#define REPO 1
#define REPS 1
#define REP_ATTN 1
#define REP_PREP 1
#define REP_FCONV 1
#define MAKE_EPOST(FROMIN, LPOST, JPOST, HASPRE, LPRE, JPRE, INST) pg8::EpiPost{p.in(0), p.in(1), p.out(), (bf16_t*)(ws + WS_H), (const float*)(ws + M_MOD), p.in(10), \
        FROMIN, LPOST, JPOST, HASPRE, LPRE, JPRE, (float*)(ws + M_ST), p.barp() + 20 * 64, 4u * (INST), \
        (INST) == 4 ? (const bf16_t*)(ws + A_Y) : (const bf16_t*)p.out(), (INST) == 4 ? (bf16_t*)nullptr : ((INST) == 3 ? (bf16_t*)(ws + A_Y) : (bf16_t*)p.out())}
#define REPG_LOOP _Pragma("unroll 1") for (int rep_ = 0; rep_ < REPG; ++rep_)
#define REPO_LOOP _Pragma("unroll 1") for (int rep_ = 0; rep_ < REPO; ++rep_)
#define GSYNC() do { _Pragma("unroll 1") for (int rs_ = 0; rs_ < REPS; ++rs_) { ++bgen; xcd_barrier(p.xbarp(), (volatile LAS unsigned*)(lds + XB_ST_OFF), gridDim.x); } } while (0)
template <class GridT>
__device__ __forceinline__ void ffn_block(const Ctx& p, LAS unsigned char* lds, GridT& grid, int layer, unsigned& bgen) {
    const int G = gridDim.x, c = blockIdx.x;
#define ws (p.ws())
    { pg8::Gemm g{(const bf16_t*)(ws + WS_H), (const bf16_t*)(ws + W_UP), 1024, 1024, 1024};
      pg8::FfnOrder S; S.init2(G, c); pg8::EpiFfnUp E{(bf16_t*)(ws + A_A2), p.in(34) + (size_t)layer * 3 * 5632, p.in(35) + (size_t)layer * 5632};
      REPG_LOOP pg8::gemm_phase(lds, g, S, E); }
    GSYNC();
    if (G == 256) {
        pg8::Gemm g{(const bf16_t*)(ws + A_A2), (const bf16_t*)(ws + W_DOWN), 2816, 2816, 2816};
        pg8::StaticOrder S; S.init(NTOK, 1024, G, c);
        if (layer == 0) { pg8::EpiPost E = MAKE_EPOST(0, 0, 1, 1, 1, 0, 2); pg8::gemm_phase(lds, g, S, E); phase_convert_l1(p, lds, 0, 576, true); }
        else { pg8::EpiPost E = MAKE_EPOST(0, 1, 1, 0, 0, 0, 4); pg8::gemm_phase(lds, g, S, E); }
        if (layer == 0) GSYNC();
    } else {
    { pg8::Gemm g{(const bf16_t*)(ws + A_A2), (const bf16_t*)(ws + W_DOWN), 2816, 2816, 2816};
      pg8::StaticOrder S; S.init(NTOK, 1024, G, c); pg8::EpiBf16 E{(bf16_t*)(ws + A_Y), 1024, 64, 0};
      REPG_LOOP pg8::gemm_phase(lds, g, S, E); }
    GSYNC();
    if (layer == 0) { post_pre<true, true, false>(p, 0, 1, 1, 0); phase_convert_l1(p, lds); GSYNC(); }
    else post_pre<true, false, false>(p, 1, 1, 0, 0);
    }
#undef ws
}

__global__ void __launch_bounds__(512, 2) mega(Params kp) {
    extern __shared__ __attribute__((aligned(16))) unsigned char smem[];
    LAS unsigned char* lds = (LAS unsigned char*)smem;
    cg::grid_group grid = cg::this_grid();
    if (threadIdx.x == 64) { ((LAS unsigned*)(lds + XB_ST_OFF))[0] = 0u; ((LAS unsigned*)(lds + XB_ST_OFF))[1] = 0u; ((LAS unsigned*)(lds + XB_ST_OFF))[4] = 0u; ((LAS unsigned*)(lds + XB_ST_OFF))[5] = 0u; }
    if (threadIdx.x < 39) ((LAS unsigned long long*)(lds + TAB_OFF))[threadIdx.x] = ((const __attribute__((address_space(4))) unsigned long long*)__builtin_amdgcn_kernarg_segment_ptr())[threadIdx.x];
    __syncthreads();
    Ctx p; p.tab = (const LAS unsigned long long*)(lds + TAB_OFF);
    const int G = gridDim.x, c = blockIdx.x;
#define ws (p.ws())

    unsigned bgen = 0;
    if (blockIdx.x == 0 && threadIdx.x < 20 + 128) __hip_atomic_store(p.barp() + threadIdx.x * 64, 0u, __ATOMIC_RELAXED, __HIP_MEMORY_SCOPE_AGENT);
    if (blockIdx.x == 0) for (int i = threadIdx.x; i < 2 * XCD_BAR_WORDS; i += 512) __hip_atomic_store(p.xbarp() + i, 0u, __ATOMIC_RELAXED, __HIP_MEMORY_SCOPE_AGENT);
    phase_prep(p, lds, 0);
    grid.sync();
    if (threadIdx.x == 0 && blockIdx.x < 128) (void)xb_add(p.xbarp() + XCD_BAR_WORDS + XB_XCNT(xb_xcc_id()), 1u);
    if (threadIdx.x == 0) (void)xb_add(p.xbarp() + XB_XCNT(xb_xcc_id()), 1u);
    _Pragma("unroll 1") for (int rep_ = 0; rep_ < REP_PREP; ++rep_) phase_prep(p, lds, 1);
    REPO_LOOP post_pre<false, true, true>(p, 0, 0, 0, 0);
    GSYNC();
    { pg8::Gemm g{(const bf16_t*)(ws + WS_H), (const bf16_t*)(ws + W_INAB), 1024, 1024, 1024};
      pg8::StaticOrder S; S.init(NTOK, 2048, G, c);
      pg8::EpiInAB E{(bf16_t*)(ws + A_AB), (bf16_t*)(ws + A_Q), (bf16_t*)(ws + A_KP), (bf16_t*)(ws + A_KS), (bf16_t*)(ws + A_VTP), (bf16_t*)(ws + A_VTS), p.out() + O_K, p.out() + O_V, (const f32x2*)(ws + M_ROPE)};
      REPG_LOOP pg8::gemm_phase(lds, g, S, E); }
    GSYNC();
    if (G == 256) {
        if (c < 128) {
            unsigned* sflag = p.barp() + 19 * 64;
            { pg8::Gemm g{(const bf16_t*)(ws + A_AB), (const bf16_t*)(ws + A_HCAT), 512, 256, 256};
              pg8::S5Order S{128, c}; pg8::EpiF32<true> E{(float*)(ws + A_E), 256};
              pg8::gemm_phase(lds, g, S, E); }
            asm volatile("s_waitcnt vmcnt(0)" ::: "memory"); __syncthreads();
            s5_rec_unit(p, c);
            asm volatile("s_waitcnt vmcnt(0)" ::: "memory"); __syncthreads();
            { pg8::Gemm g{(const bf16_t*)(ws + A_AB), (const bf16_t*)(ws + A_WB), 512, 512, 512};
              pg8::S5Order S{128, c}; pg8::EpiS5B E{(bf16_t*)(ws + A_YS)};
              pg8::gemm_phase(lds, g, S, E); }
            asm volatile("s_waitcnt vmcnt(0)" ::: "memory"); __syncthreads();
            if (threadIdx.x == 0) { __builtin_amdgcn_fence(__ATOMIC_RELEASE, "agent"); asm volatile("s_waitcnt vmcnt(0)" ::: "memory");
                __hip_atomic_fetch_add(sflag, 1u, __ATOMIC_RELAXED, __HIP_MEMORY_SCOPE_AGENT); }
            attn_item(p, lds, true, c >> 6, (c >> 4) & 3, c & 15);
        } else {
            attn_item(p, lds, true, c >> 6, (c >> 4) & 3, c & 15);
            _Pragma("unroll 1") for (int u2 = 0; u2 < 2; ++u2) { const int it = 2 * (c - 128) + u2; attn_item(p, lds, false, it >> 3, (it >> 1) & 3, it & 1); }
            __syncthreads();
            if (threadIdx.x == 0) { unsigned* rel = p.barp() + 10 * 64 + 9 * 64; unsigned spins = 0;
                while (__hip_atomic_load(rel, __ATOMIC_RELAXED, __HIP_MEMORY_SCOPE_AGENT) < 128u && ++spins < (1u << 24)) __builtin_amdgcn_s_sleep(1);
                __builtin_amdgcn_fence(__ATOMIC_ACQUIRE, "agent");
                asm volatile("s_waitcnt vmcnt(0)" ::: "memory"); }
            __syncthreads();
            { pg8::Gemm g{(const bf16_t*)(ws + A_YS), (const bf16_t*)(ws + W_GLU), 512, 512, 512};
              pg8::StaticOrder S; S.init(NTOK, 512, 128, c - 128); pg8::EpiGLU E{(const bf16_t*)(ws + A_YS), (bf16_t*)(ws + WS_H), p.in(20)};
              pg8::gemm_phase(lds, g, S, E); }
        }
        GSYNC();
    } else {
    { pg8::Gemm g{(const bf16_t*)(ws + A_AB), (const bf16_t*)(ws + A_HCAT), 512, 256, 256};
      pg8::S5Order S{G, c}; pg8::EpiF32<true> E{(float*)(ws + A_E), 256};
      pg8::gemm_phase(lds, g, S, E); }
    phase_attn(p, lds);
    GSYNC();
    phase_s5_rec(p, c, G);
    GSYNC();
    { pg8::Gemm g{(const bf16_t*)(ws + A_AB), (const bf16_t*)(ws + A_WB), 512, 512, 512};
      pg8::S5Order S{G, c}; pg8::EpiS5B E{(bf16_t*)(ws + A_YS)};
      pg8::gemm_phase(lds, g, S, E); }
    GSYNC();
    { pg8::Gemm g{(const bf16_t*)(ws + A_YS), (const bf16_t*)(ws + W_GLU), 512, 512, 512};
      pg8::StaticOrder S; S.init(NTOK, 512, G, c); pg8::EpiGLU E{(const bf16_t*)(ws + A_YS), (bf16_t*)(ws + WS_H), p.in(20)};
      pg8::gemm_phase(lds, g, S, E); }
    GSYNC();
    }
    if (G == 256) {
        pg8::Gemm g{(const bf16_t*)(ws + WS_H), (const bf16_t*)(ws + W_OUT), 1024, 1024, 1024};
        pg8::StaticOrder S; S.init(NTOK, 1024, G, c); pg8::EpiPost E = MAKE_EPOST(0, 0, 0, 1, 0, 1, 1);
        pg8::gemm_phase(lds, g, S, E);
        GSYNC();
    } else {
    { pg8::Gemm g{(const bf16_t*)(ws + WS_H), (const bf16_t*)(ws + W_OUT), 1024, 1024, 1024};
      pg8::StaticOrder S; S.init(NTOK, 1024, G, c); pg8::EpiBf16 E{(bf16_t*)(ws + A_Y), 1024, 64, 0};
      REPG_LOOP pg8::gemm_phase(lds, g, S, E); }
    GSYNC();
    post_pre<true, true, true>(p, 0, 0, 0, 1);
    GSYNC();
    }
    ffn_block(p, lds, grid, 0, bgen);
    { pg8::Gemm g{(const bf16_t*)(ws + WS_H), (const bf16_t*)(ws + W_INCD), 1024, 1024, 1024};
      pg8::StaticOrder S; S.init(NTOK, 2560, G, c); pg8::EpiBf16 E{(bf16_t*)(ws + A_XIN), 512, 2, (size_t)NTOK * 512};
      REPG_LOOP pg8::gemm_phase(lds, g, S, E); }
    GSYNC();
    REPO_LOOP phase_cd_conv(p);
    if (G == 256) phase_convert_l1(p, lds, 576, 752, false);
    GSYNC();
    { pg8::Gemm g{(const bf16_t*)(ws + A_XC), (const bf16_t*)(ws + W_GATE), 512, 512, 256};
      pg8::GateOrder S; S.init(NTOK, 2048, G, c);
      pg8::EpiGate E{(const bf16_t*)(ws + A_XC), (bf16_t*)(ws + A_LA), (bf16_t*)(ws + A_BV), p.in(29), p.in(31), (const float*)(ws + M_SP8)};
      REPG_LOOP pg8::gemm_phase(lds, g, S, E); }
    GSYNC();
    phase_lru_a(p, lds);
    GSYNC();
    phase_lru_b(p, lds);
    GSYNC();
    if (G == 256) {
        pg8::Gemm g{(const bf16_t*)(ws + WS_H), (const bf16_t*)(ws + W_OUT), 1024, 1024, 1024};
        pg8::StaticOrder S; S.init(NTOK, 1024, G, c); pg8::EpiPost E = MAKE_EPOST(0, 1, 0, 1, 1, 1, 3);
        pg8::gemm_phase(lds, g, S, E);
        GSYNC();
    } else {
    { pg8::Gemm g{(const bf16_t*)(ws + WS_H), (const bf16_t*)(ws + W_OUT), 1024, 1024, 1024};
      pg8::StaticOrder S; S.init(NTOK, 1024, G, c); pg8::EpiBf16 E{(bf16_t*)(ws + A_Y), 1024, 64, 0};
      REPG_LOOP pg8::gemm_phase(lds, g, S, E); }
    GSYNC();
    post_pre<true, true, false>(p, 1, 0, 1, 1);
    GSYNC();
    }
    ffn_block(p, lds, grid, 1, bgen);
#undef ws
}

extern "C" void kernel_launch(void* const* d_in, const int* in_sizes, int n_in, void* d_out, int out_size, void* d_ws, size_t ws_size, hipStream_t stream) {
    static int grid_blocks = 0;
    if (!grid_blocks) {
        int dev = 0, cus = 0, per_cu = 0;
        hipGetDevice(&dev);
        hipDeviceGetAttribute(&cus, hipDeviceAttributeMultiprocessorCount, dev);
        hipFuncSetAttribute((const void*)mega, hipFuncAttributeMaxDynamicSharedMemorySize, LDS_BYTES);
        hipOccupancyMaxActiveBlocksPerMultiprocessor(&per_cu, (const void*)mega, 512, LDS_BYTES);
        if (per_cu < 1) { fprintf(stderr, "kernel_launch: occupancy query says %d blocks per CU\n", per_cu); per_cu = 1; }
        (void)hipGetLastError();
        grid_blocks = cus;
        if (n_in != 37 || ws_size < WS_NEED) fprintf(stderr, "kernel_launch: unexpected n_in %d or ws_size %zu (< %zu)\n", n_in, ws_size, (size_t)WS_NEED);
    }
    Params p{};
    for (int i = 0; i < 37; ++i) p.in[i] = (const float*)d_in[i];
    p.out = (float*)d_out; p.ws = (unsigned char*)d_ws;
    void* args[] = {&p};
    hipError_t e = hipLaunchCooperativeKernel((const void*)mega, dim3(grid_blocks), dim3(512), args, LDS_BYTES, stream);
    if (e != hipSuccess) fprintf(stderr, "cooperative launch failed: %s (grid %d)\n", hipGetErrorString(e), grid_blocks);
}
```
